# Optimizing an MI355X kernel written in HIP

```python
import numpy as np
import jax, jax.numpy as jnp
from jax import lax

D_MODEL = 1024
BATCH = 32
SEQ = 2048
DEPTH = 4

NSA_HEADS = 8
HEAD_DIM = 64
NSA_KV_GROUPS = 2
HEADS_PER_GROUP = NSA_HEADS // NSA_KV_GROUPS
NSA_WIDTH = NSA_HEADS * HEAD_DIM
KV_WIDTH = NSA_KV_GROUPS * HEAD_DIM
CMP_LEN = 32
CMP_STRIDE = 16
CMP_HIDDEN = 256
SEL_BLOCK = 64
SEL_TOPN = 8
WINDOW = 512
Q_CHUNK = 64
ATTN_SCALE = HEAD_DIM ** -0.5
POOL_GROUPS = 4
POOL_WINDOWS = (2, 4, 8, 16)
POOL_GROUP_WIDTH = 128
POOL_WIDTH = POOL_GROUPS * POOL_GROUP_WIDTH
N_MERGE = 2
IN_COLS = NSA_WIDTH + 6 * KV_WIDTH + 3 * NSA_HEADS + POOL_WIDTH + N_MERGE * D_MODEL
D_FF = 2816
N_EXPERTS = 8
TOP_K = 2
D_FF_EXPERT = 3584
MOE_ROW_BLOCK = 512
N_DENSE = (DEPTH + 1) // 2
N_MOE = DEPTH // 2
RMS_EPS = 1e-6
NEG_INF = -1e30
FORCE = 1e9

kernel_name = "hybrid_nsa_pool_moe_trunk"


def rms_norm(x, g):
    xf = x.astype(jnp.float32)
    y = xf * lax.rsqrt(jnp.mean(xf * xf, axis=-1, keepdims=True) + RMS_EPS)
    return (y * g.astype(jnp.float32)).astype(x.dtype)


def swiglu(h, w_gate, w_up, w_down):
    return (jax.nn.silu(h @ w_gate) * (h @ w_up)) @ w_down


def compress_tokens(k, pos, w1, w2):
    B, S, G, dh = k.shape
    n_cmp = (S - CMP_LEN) // CMP_STRIDE + 1
    idx = np.arange(n_cmp)[:, None] * CMP_STRIDE + np.arange(CMP_LEN)[None, :]
    blocks = k[:, idx] + pos[:, None, :]
    blocks = blocks.transpose(0, 1, 3, 2, 4).reshape(B, n_cmp, G, CMP_LEN * dh)
    return jax.nn.gelu(blocks @ w1) @ w2


def compressed_attention(q, k_c, v_c):
    S = q.shape[1]
    n_cmp = k_c.shape[1]
    t = jnp.arange(S)
    end = jnp.arange(n_cmp) * CMP_STRIDE + CMP_LEN - 1
    valid = end[None, :] <= t[:, None]
    s = jnp.einsum('bsgrd,bngd->bgrsn', q, k_c).astype(jnp.float32) * ATTN_SCALE
    s = jnp.where(valid, s, NEG_INF)
    p = jax.nn.softmax(s, axis=-1) * valid
    o = jnp.einsum('bgrsn,bngd->bsgrd', p.astype(v_c.dtype), v_c)
    return o, p


def cmp_to_sel_map(n_cmp, n_blk):
    cs = np.arange(n_cmp) * CMP_STRIDE
    ce = cs + CMP_LEN - 1
    bs = np.arange(n_blk) * SEL_BLOCK
    be = bs + SEL_BLOCK - 1
    m = (cs[:, None] <= be[None, :]) & (ce[:, None] >= bs[None, :])
    return jnp.asarray(m.astype(np.float32))


def select_blocks(p_cmp, S):
    n_cmp = p_cmp.shape[-1]
    n_blk = S // SEL_BLOCK
    imp = jnp.einsum('bgrsn,nj->bgsj', p_cmp, cmp_to_sel_map(n_cmp, n_blk))
    t = jnp.arange(S)[:, None]
    blk = jnp.arange(n_blk)[None, :]
    cur = t // SEL_BLOCK
    imp = jnp.where(blk > cur, -FORCE, imp)
    imp = jnp.where((blk == 0) | (blk == cur), FORCE, imp)
    _, idx = lax.top_k(imp, min(SEL_TOPN, n_blk))
    return idx


def selected_and_window_attention(q, k_sel, v_sel, k_win, v_win, sel_idx):
    B, S, G, R, dh = q.shape
    n_blk = S // SEL_BLOCK
    kb = k_sel.reshape(B, n_blk, SEL_BLOCK, G, dh).transpose(0, 3, 1, 2, 4)
    vb = v_sel.reshape(B, n_blk, SEL_BLOCK, G, dh).transpose(0, 3, 1, 2, 4)
    pad = ((0, 0), (WINDOW, 0), (0, 0), (0, 0))
    kw = jnp.pad(k_win, pad)
    vw = jnp.pad(v_win, pad)
    bi = jnp.arange(B)[:, None, None, None]
    gi = jnp.arange(G)[None, :, None, None]
    span = WINDOW + Q_CHUNK

    def chunk(c):
        s0 = c * Q_CHUNK
        qc = lax.dynamic_slice_in_dim(q, s0, Q_CHUNK, axis=1)
        t = s0 + jnp.arange(Q_CHUNK)
        ic = lax.dynamic_slice_in_dim(sel_idx, s0, Q_CHUNK, axis=2)
        ks = kb[bi, gi, ic]
        vs = vb[bi, gi, ic]
        kpos = ic[..., None] * SEL_BLOCK + jnp.arange(SEL_BLOCK)
        m = kpos <= t[None, None, :, None, None]
        sc = jnp.einsum('bqgrd,bgqnkd->bgrqnk', qc, ks).astype(jnp.float32) * ATTN_SCALE
        sc = jnp.where(m[:, :, None], sc, NEG_INF)
        ps = jax.nn.softmax(sc.reshape(B, G, R, Q_CHUNK, -1), axis=-1).reshape(sc.shape)
        o_sel = jnp.einsum('bgrqnk,bgqnkd->bqgrd', ps.astype(vs.dtype), vs)
        kwc = lax.dynamic_slice_in_dim(kw, s0, span, axis=1)
        vwc = lax.dynamic_slice_in_dim(vw, s0, span, axis=1)
        kp = s0 - WINDOW + jnp.arange(span)
        mw = (kp[None, :] <= t[:, None]) & (kp[None, :] > t[:, None] - WINDOW) & (kp[None, :] >= 0)
        sw = jnp.einsum('bqgrd,bkgd->bgrqk', qc, kwc).astype(jnp.float32) * ATTN_SCALE
        sw = jnp.where(mw, sw, NEG_INF)
        pw = jax.nn.softmax(sw, axis=-1)
        o_win = jnp.einsum('bgrqk,bkgd->bqgrd', pw.astype(vwc.dtype), vwc)
        return o_sel, o_win

    o_sel, o_win = lax.map(chunk, jnp.arange(S // Q_CHUNK))
    o_sel = jnp.moveaxis(o_sel, 0, 1).reshape(B, S, G, R, dh)
    o_win = jnp.moveaxis(o_win, 0, 1).reshape(B, S, G, R, dh)
    return o_sel, o_win


def multiscale_pool(u, pool_w, pool_scale):
    B, S, _ = u.shape
    uf = u.astype(jnp.float32).reshape(B, S, POOL_GROUPS, POOL_GROUP_WIDTH)
    csum = jnp.cumsum(uf, axis=1)
    outs = []
    for gi, w in enumerate(POOL_WINDOWS):
        cg = csum[:, :, gi]
        lag = jnp.pad(cg, ((0, 0), (w, 0), (0, 0)))[:, :S]
        cnt = jnp.minimum(jnp.arange(1, S + 1), w).astype(jnp.float32)
        outs.append((cg - lag) / cnt[None, :, None] - uf[:, :, gi])
    pooled = jnp.stack(outs, axis=2).astype(u.dtype)
    mixed = jnp.einsum('bsgc,gcd->bsgd', pooled, pool_w)
    return mixed.reshape(B, S, POOL_WIDTH) * pool_scale


def token_mixer(a, w_in, cmp_pos, cmp_w1, cmp_w2, w_nsa_up, pool_w, pool_scale, w_pool_up, w_out):
    B, S, _ = a.shape
    G, R, dh = NSA_KV_GROUPS, HEADS_PER_GROUP, HEAD_DIM
    sizes = [NSA_WIDTH, 6 * KV_WIDTH, 3 * NSA_HEADS, POOL_WIDTH]
    offsets = np.cumsum(sizes).tolist()
    proj = a @ w_in
    q, kv, gl, u, mg = jnp.split(proj, offsets, axis=-1)
    q = q.reshape(B, S, G, R, dh)
    kv = kv.reshape(B, S, 6, G, dh)
    k_cmp, v_cmp, k_sel, v_sel, k_win, v_win = (kv[:, :, j] for j in range(6))
    kc = compress_tokens(k_cmp, cmp_pos[0], cmp_w1[0], cmp_w2[0])
    vc = compress_tokens(v_cmp, cmp_pos[1], cmp_w1[1], cmp_w2[1])
    o_cmp, p_cmp = compressed_attention(q, kc, vc)
    sel_idx = select_blocks(p_cmp, S)
    o_sel, o_win = selected_and_window_attention(q, k_sel, v_sel, k_win, v_win, sel_idx)
    g = jax.nn.sigmoid(gl).reshape(B, S, G, R, 3)
    o_nsa = (g[..., 0:1] * o_cmp + g[..., 1:2] * o_sel + g[..., 2:3] * o_win).reshape(B, S, NSA_WIDTH)
    y_pool = multiscale_pool(u, pool_w, pool_scale)
    mg = jax.nn.sigmoid(mg).reshape(B, S, N_MERGE, D_MODEL)
    merged = mg[:, :, 0] * (o_nsa @ w_nsa_up) + mg[:, :, 1] * (y_pool @ w_pool_up)
    return merged @ w_out


def moe_swiglu(h, w_router, b_router, w_gate, w_up, w_down):
    T, D = h.shape
    E, K, BLK = N_EXPERTS, TOP_K, MOE_ROW_BLOCK
    logits = (h @ w_router).astype(jnp.float32) + b_router.astype(jnp.float32)
    top_logit, top_e = lax.top_k(logits, K)
    gates = jax.nn.softmax(top_logit, axis=-1)
    flat_e = top_e.reshape(-1)
    flat_tok = jnp.repeat(jnp.arange(T, dtype=jnp.int32), K)
    order = jnp.argsort(flat_e)
    e_s = flat_e[order]
    tok_s = flat_tok[order]
    g_s = gates.reshape(-1)[order]
    counts = jnp.bincount(flat_e, length=E)
    padded = (counts + BLK - 1) // BLK * BLK
    pad_end = jnp.cumsum(padded)
    pad_start = pad_end - padded
    grp_start = jnp.cumsum(counts) - counts
    dest = pad_start[e_s] + jnp.arange(T * K) - grp_start[e_s]
    n_blocks = -(-(T * K + E * (BLK - 1)) // BLK)
    x_buf = jnp.zeros((n_blocks * BLK, D), h.dtype).at[dest].set(h[tok_s])
    block_start = jnp.arange(n_blocks) * BLK
    block_e = jnp.minimum(jnp.sum(block_start[:, None] >= pad_end[None, :], axis=1), E - 1)

    def expert_block(args):
        xb, e = args
        return swiglu(xb, w_gate[e], w_up[e], w_down[e])

    y_buf = lax.map(expert_block, (x_buf.reshape(n_blocks, BLK, D), block_e))
    y = y_buf.reshape(n_blocks * BLK, D)[dest] * g_s[:, None].astype(h.dtype)
    return jax.ops.segment_sum(y, tok_s, num_segments=T)


def setup_inputs(seed: int = 0) -> dict:
    key = jax.random.key(seed)
    ks = jax.random.split(key, 22)

    def nrm(k, shape, fan_in):
        return jax.random.normal(k, shape, jnp.float32) * (fan_in ** -0.5)

    def gain(k, shape):
        return 1.0 + 0.05 * jax.random.normal(k, shape, jnp.float32)

    return {
        "x": jax.random.normal(ks[0], (BATCH, SEQ, D_MODEL), jnp.float32),
        "norm_mix_g": gain(ks[1], (DEPTH, D_MODEL)),
        "w_in": nrm(ks[2], (DEPTH, D_MODEL, IN_COLS), D_MODEL),
        "cmp_pos": 0.1 * jax.random.normal(ks[3], (DEPTH, 2, CMP_LEN, HEAD_DIM), jnp.float32),
        "cmp_w1": nrm(ks[4], (DEPTH, 2, CMP_LEN * HEAD_DIM, CMP_HIDDEN), CMP_LEN * HEAD_DIM),
        "cmp_w2": nrm(ks[5], (DEPTH, 2, CMP_HIDDEN, HEAD_DIM), CMP_HIDDEN),
        "w_nsa_up": nrm(ks[6], (DEPTH, NSA_WIDTH, D_MODEL), NSA_WIDTH),
        "pool_w": nrm(ks[7], (DEPTH, POOL_GROUPS, POOL_GROUP_WIDTH, POOL_GROUP_WIDTH), POOL_GROUP_WIDTH),
        "pool_scale": 1.0 + 0.1 * jax.random.normal(ks[8], (DEPTH, POOL_WIDTH), jnp.float32),
        "w_pool_up": nrm(ks[9], (DEPTH, POOL_WIDTH, D_MODEL), POOL_WIDTH),
        "w_out": nrm(ks[10], (DEPTH, D_MODEL, D_MODEL), D_MODEL),
        "norm_ffn_g": gain(ks[11], (DEPTH, D_MODEL)),
        "ffn_w_gate": nrm(ks[12], (N_DENSE, D_MODEL, D_FF), D_MODEL),
        "ffn_w_up": nrm(ks[13], (N_DENSE, D_MODEL, D_FF), D_MODEL),
        "ffn_w_down": nrm(ks[14], (N_DENSE, D_FF, D_MODEL), D_FF),
        "moe_w_router": nrm(ks[15], (N_MOE, D_MODEL, N_EXPERTS), D_MODEL),
        "moe_b_router": 0.01 * jax.random.normal(ks[16], (N_MOE, N_EXPERTS), jnp.float32),
        "moe_w_gate": nrm(ks[17], (N_MOE, N_EXPERTS, D_MODEL, D_FF_EXPERT), D_MODEL),
        "moe_w_up": nrm(ks[18], (N_MOE, N_EXPERTS, D_MODEL, D_FF_EXPERT), D_MODEL),
        "moe_w_down": nrm(ks[19], (N_MOE, N_EXPERTS, D_FF_EXPERT, D_MODEL), D_FF_EXPERT),
        "final_norm_g": gain(ks[20], (D_MODEL,)),
    }


def reference(x, norm_mix_g, w_in, cmp_pos, cmp_w1, cmp_w2, w_nsa_up, pool_w, pool_scale, w_pool_up,
              w_out, norm_ffn_g, ffn_w_gate, ffn_w_up, ffn_w_down, moe_w_router, moe_b_router,
              moe_w_gate, moe_w_up, moe_w_down, final_norm_g):
    B, S, D = x.shape
    h = x
    for i in range(DEPTH):
        a = rms_norm(h, norm_mix_g[i])
        h = h + token_mixer(a, w_in[i], cmp_pos[i], cmp_w1[i], cmp_w2[i], w_nsa_up[i],
                            pool_w[i], pool_scale[i], w_pool_up[i], w_out[i])
        f = rms_norm(h, norm_ffn_g[i])
        j = i // 2
        if i % 2 == 0:
            h = h + swiglu(f, ffn_w_gate[j], ffn_w_up[j], ffn_w_down[j])
        else:
            h = h + moe_swiglu(f.reshape(B * S, D), moe_w_router[j], moe_b_router[j],
                               moe_w_gate[j], moe_w_up[j], moe_w_down[j]).reshape(B, S, D)
    return rms_norm(h, final_norm_g)
```

```cpp
#include <hip/hip_runtime.h>
#include <cstdio>
#include <cstdint>

#ifndef GEMM_ALIGN_EPI
#define GEMM_ALIGN_EPI true
#endif
#ifndef MK_PER_PHASE
#define MK_PER_PHASE 0
#endif

#define LAS __attribute__((address_space(3)))
typedef unsigned short bf16_t;
typedef short bf16x8 __attribute__((ext_vector_type(8)));
typedef float f32x4 __attribute__((ext_vector_type(4)));
typedef float f32x2 __attribute__((ext_vector_type(2)));
typedef unsigned u32x4 __attribute__((ext_vector_type(4)));
typedef unsigned u32x2 __attribute__((ext_vector_type(2)));

constexpr int T_ = 65536, S_ = 2048, NB_ = 32, D_ = 1024, DEPTH_ = 4;
constexpr int INC_ = 3864;
constexpr int DFF_ = 2816, DFE_ = 3584, NE_ = 8;
constexpr int MOE_CH_TILES = 64;
constexpr int MOE_NFULL = 512 / MOE_CH_TILES;
constexpr int MOE_MAX_TILES = 520;
constexpr int MOE_MAX_CHUNKS = MOE_NFULL + 1;
constexpr int MOE_ROWS = MOE_MAX_TILES * 256;
constexpr int YB_DUMMY = 131072;

constexpr size_t WS_CTL = 0, CTL_BYTES = 65536;
constexpr size_t CTL_CNT = 16384;
constexpr size_t WS_BUFA = WS_CTL + CTL_BYTES;
constexpr size_t SZ_BUFA = (size_t)T_ * 1024 * 2;
constexpr size_t WS_R1 = WS_BUFA + SZ_BUFA;
constexpr size_t R1_Q = WS_R1;
constexpr size_t R1_KV = R1_Q + (size_t)T_ * 512 * 2;
constexpr size_t R1_U = R1_KV + (size_t)12 * T_ * 64 * 2 + 65536;
constexpr size_t R1_GT = R1_U + (size_t)T_ * 512 * 2;
constexpr size_t R1_RATIO = R1_GT + (size_t)T_ * 32 * 4;
constexpr size_t R1_S1 = R1_RATIO + (size_t)T_ * 1024 * 2;
constexpr size_t R1_END = R1_S1 + (size_t)T_ * 1024 * 2;
constexpr size_t R1_MERGED = R1_Q;
constexpr size_t R1_HF = WS_R1;
constexpr size_t R1_HM = WS_R1;
constexpr size_t R1_YB = R1_HM + (size_t)MOE_CH_TILES * 256 * DFE_ * 2;
constexpr size_t R1_YB_END = R1_YB + (size_t)(131072 + 256) * 1024 * 2;
static_assert(R1_YB_END <= R1_END, "moe overlay");
static_assert((size_t)T_ * DFF_ * 2 <= R1_END - WS_R1, "dense overlay");
constexpr size_t WS_HC = R1_END;
constexpr size_t WS_KC = WS_HC + (size_t)16384 * 256 * 2;
constexpr size_t WS_TOKE = WS_KC + (size_t)16384 * 64 * 2;
constexpr size_t WS_TOKP = WS_TOKE + (size_t)T_ * 2 * 4;
constexpr size_t WS_TOKG = WS_TOKP + (size_t)T_ * 2 * 4;
constexpr size_t WS_ROWT = WS_TOKG + (size_t)T_ * 2 * 4;
constexpr size_t WS_ROWD = WS_ROWT + (size_t)MOE_ROWS * 4 + 1024;
constexpr size_t WS_W = WS_ROWD + (size_t)MOE_ROWS * 4 + 1024;
constexpr size_t MIX_IN = 0;
constexpr size_t MIX_C1 = MIX_IN + (size_t)4096 * 1024 * 2;
constexpr size_t MIX_B1 = MIX_C1 + (size_t)2 * 256 * 2048 * 2;
constexpr size_t MIX_M = MIX_B1 + 4096;
constexpr size_t MIX_O = MIX_M + (size_t)1024 * 1024 * 2;
constexpr size_t MIX_BYTES = MIX_O + (size_t)1024 * 1024 * 2;
#define W_IN_(L) (WS_W + (size_t)((L) & 1) * MIX_BYTES + MIX_IN)
#define W_C1_(L) (WS_W + (size_t)((L) & 1) * MIX_BYTES + MIX_C1)
#define W_B1_(L) (WS_W + (size_t)((L) & 1) * MIX_BYTES + MIX_B1)
#define W_M_(L)  (WS_W + (size_t)((L) & 1) * MIX_BYTES + MIX_M)
#define W_O_(L)  (WS_W + (size_t)((L) & 1) * MIX_BYTES + MIX_O)
constexpr size_t W_FF = WS_W + 2 * MIX_BYTES;
constexpr size_t W_FFD_DENSE = W_FF + (size_t)2 * DFF_ * 1024 * 2;
constexpr size_t W_FFD_MOE = W_FF + (size_t)NE_ * 2 * DFE_ * 1024 * 2;
constexpr size_t WS_HM1 = W_FFD_MOE + (size_t)NE_ * 1024 * DFE_ * 2;
constexpr size_t WS_HM2 = WS_HM1 + (size_t)MOE_CH_TILES * 256 * DFE_ * 2;
constexpr size_t WS_H = WS_HM2 + (size_t)8 * 256 * DFE_ * 2;
constexpr size_t WS_END = WS_H + (size_t)T_ * 1024 * 2;
static_assert(WS_END <= (size_t)1157000000, "workspace budget (sum of the inputs = 1,157,673,024 bytes)");

__device__ __forceinline__ float bf2f(bf16_t v) { return __uint_as_float(((unsigned)v) << 16); }
__device__ __forceinline__ bf16_t f2bf(float f) { unsigned u = __float_as_uint(f); u += 0x7FFFu + ((u >> 16) & 1u); return (bf16_t)(u >> 16); }
__device__ __forceinline__ unsigned cvt_pk_bf16(float lo, float hi) { unsigned r; asm("v_cvt_pk_bf16_f32 %0, %1, %2" : "=v"(r) : "v"(lo), "v"(hi)); return r; }
__device__ __forceinline__ float wave_sum(float v) {
#pragma unroll
    for (int o = 32; o >= 1; o >>= 1) v += __shfl_xor(v, o);
    return v; }
__device__ __forceinline__ float wave_max(float v) {
#pragma unroll
    for (int o = 32; o >= 1; o >>= 1) v = fmaxf(v, __shfl_xor(v, o));
    return v; }
__device__ __forceinline__ float frcp(float x) { return __builtin_amdgcn_rcpf(x); }
__device__ __forceinline__ float fexpn(float x) { return __builtin_amdgcn_exp2f(x * -1.4426950408889634f); }
__device__ __forceinline__ float sigmoidf_(float x) { x = fminf(fmaxf(x, -30.f), 30.f); return frcp(1.0f + fexpn(x)); }
#define LDS_FENCE() asm volatile("s_waitcnt lgkmcnt(0)" ::: "memory")

#define XB_TMO      128
#define XB_XCNT(j)  (256  + 64 * (j))
#define XB_XSUB(j)  (1280 + 64 * (j))
#define XB_XGEN(j)  (2304 + 64 * (j))
#define XB_TOP      3328
#define XB_TOPGEN   3392
#define XCD_BAR_WORDS 3456
#define XB_SPIN_CAP (1u << 21)
__device__ __forceinline__ unsigned xb_ld(unsigned* p)              { return __hip_atomic_load(p, __ATOMIC_RELAXED, __HIP_MEMORY_SCOPE_AGENT); }
__device__ __forceinline__ unsigned xb_add(unsigned* p, unsigned v) { return __hip_atomic_fetch_add(p, v, __ATOMIC_RELAXED, __HIP_MEMORY_SCOPE_AGENT); }
__device__ __forceinline__ unsigned xb_xcc_id() { return (unsigned)__builtin_amdgcn_s_getreg((3 << 11) | 20) & 0xFu; }
#define XB_SPIN(cond, bar) do { unsigned _sp = 0; while (cond) { __builtin_amdgcn_s_sleep(1); \
    if ((++_sp & 255u) == 0u) { if (xb_ld(&(bar)[XB_TMO])) break; if (_sp > XB_SPIN_CAP) { atomicAdd(&(bar)[XB_TMO], 1u); break; } } } } while (0)
struct XcdBarrier { unsigned* bar; unsigned x; volatile LAS unsigned* st; };
__device__ __forceinline__ XcdBarrier xcd_barrier_post(unsigned* bar, volatile LAS unsigned* st) {
    XcdBarrier b; b.bar = bar; b.x = xb_xcc_id(); b.st = st;
    if (threadIdx.x == 0) (void)xb_add(&bar[XB_XCNT(b.x)], 1u);
    return b;
}
__device__ __forceinline__ void xcd_barrier_complete(unsigned* bar, unsigned x, unsigned& nloc, unsigned& nx) {
    asm volatile("" : "+s"(x));
    const unsigned G = gridDim.x * gridDim.y * gridDim.z;
    unsigned sum, cnt, mine, sp = 0u;
    for (;;) {
        sum = 0u; cnt = 0u; mine = 0u;
#pragma unroll
        for (unsigned j = 0; j < 16; ++j) { const unsigned c = xb_ld(&bar[XB_XCNT(j)]); sum += c; cnt += (c > 0u) ? 1u : 0u; mine = (j == x) ? c : mine; }
        if (sum == G) break;
        __builtin_amdgcn_s_sleep(1);
        if ((++sp & 255u) == 0u) { if (xb_ld(&bar[XB_TMO])) break; if (sp > XB_SPIN_CAP) { atomicAdd(&bar[XB_TMO], 1u); break; } }
    }
    nloc = mine > 0u ? mine : 1u; nx = cnt > 0u ? cnt : 1u;
}
__device__ __forceinline__ void xcd_barrier(const XcdBarrier& b) {
    asm volatile("s_waitcnt vmcnt(0)" ::: "memory");
    __syncthreads();
    if (threadIdx.x == 0) {
        unsigned* bar = b.bar;
        __builtin_amdgcn_s_waitcnt(0);
        unsigned nloc = b.st[0], nx = b.st[1];
        if (nloc == 0u) { xcd_barrier_complete(bar, b.x, nloc, nx); b.st[0] = nloc; b.st[1] = nx; }
        const unsigned old = xb_add(&bar[XB_XSUB(b.x)], 1u);
        const unsigned gen = old / nloc;
        if (old + 1u == (gen + 1u) * nloc) {
            __builtin_amdgcn_fence(__ATOMIC_RELEASE, "agent");
            asm volatile("s_waitcnt vmcnt(0)" ::: "memory");
            const unsigned og = xb_add(&bar[XB_TOP], 1u);
            const unsigned tg = og / nx;
            if (og + 1u == (tg + 1u) * nx) xb_add(&bar[XB_TOPGEN], 1u);
            else XB_SPIN(xb_ld(&bar[XB_TOPGEN]) == tg, bar);
            __builtin_amdgcn_fence(__ATOMIC_ACQUIRE, "agent");
            xb_add(&bar[XB_XGEN(b.x)], 1u);
            asm volatile("s_waitcnt vmcnt(0)" ::: "memory");
        } else {
            XB_SPIN(xb_ld(&bar[XB_XGEN(b.x)]) == gen, bar);
            __builtin_amdgcn_fence(__ATOMIC_ACQUIRE, "agent");
            asm volatile("s_waitcnt vmcnt(0)" ::: "memory");
        }
    }
    __syncthreads();
}

namespace pg8 {
constexpr int BM = 256, BK = 64, HALF = 128, HTB = HALF * BK * 2, STAGE_BYTES = 8 * HTB, NXCD = 8, WGM = 8;
__host__ __device__ __forceinline__ int lds_byte(int r, int c) { const int st = (r >> 4) * 2 + (c >> 5), rr = r & 15, cc = c & 31, ob = rr * 64 + cc * 2; return st * 1024 + (ob ^ (((ob >> 9) & 1) << 5)); }
__host__ __device__ __forceinline__ void stage_rc(int b, int& R, int& C) { const int st = b / 1024, sb = b % 1024, swz = sb ^ (((sb >> 9) & 1) << 5); R = (st >> 1) * 16 + swz / 64; C = (st & 1) * 32 + (swz % 64) / 2; }
__host__ __device__ __forceinline__ int perm32(int rho) { const int n = rho >> 4, i = rho & 15; return 8 * (i >> 2) + 4 * n + (i & 3); }

struct Unit { int pm, pn, pb; };
struct Gemm { const bf16_t* A; const bf16_t* Bt; int lda, K; };

struct Order {
    int nM, nN, nwg, G, c, mode, pbdiv, tile0, nsk, wgm; int ts[NE_ + 1];
    __device__ __forceinline__ void init(int nM_, int nN_, int G_, int c_) { nM = nM_; nN = nN_; nwg = nM * nN; G = G_; c = c_; mode = 0; pbdiv = 1; tile0 = 0; nsk = 0; wgm = WGM; }
    __device__ __forceinline__ void set_skip(int n) { nsk = (n > 0 && n * 5 <= G && nwg >= 6 * G) ? n : 0; }
    __device__ __forceinline__ bool next(int i, Unit& u) const {
        long L = (long)i * G + c;
        if (nsk > 0) { if (c < nsk) L += 4L * G;
            else if (L >= nwg) { const int e = c - (G - 4 * nsk); if (e < 0 || L - G >= nwg) return false; L = (long)(e & 3) * G + (e >> 2); } }
        if (L >= nwg) return false;
        int wgid = (int)L; { const int q = nwg / NXCD, r = nwg % NXCD, xcd = wgid % NXCD, off = wgid / NXCD; wgid = (xcd < r ? xcd * (q + 1) : r * (q + 1) + (xcd - r) * q) + off; }
        const int nig = wgm * nN, gid = wgid / nig, fm = gid * wgm, gsz = (nM - fm) < wgm ? (nM - fm) : wgm;
        u.pm = fm + ((wgid % nig) % gsz); u.pn = (wgid % nig) / gsz;
        if (mode == 0) u.pb = u.pn;
        else if (mode == 1) u.pb = (u.pm / pbdiv) * nN + u.pn;
        else { const int tile = tile0 + u.pm; int e = 0;
#pragma unroll
            for (int k = 1; k < NE_; ++k) e += (tile >= ts[k]) ? 1 : 0;
            u.pb = e * nN + u.pn; }
        return true;
    }
};

template <class Epi, bool GATHER = false>
__device__ __forceinline__ void gemm_phase(LAS unsigned char* lds, int wave_id, const Gemm g, const Order& S, const Epi& E, const int* rowtok = nullptr) {
    int lane; asm volatile("v_mbcnt_lo_u32_b32 %0, -1, 0\n\tv_mbcnt_hi_u32_b32 %0, -1, %0" : "=v"(lane));
    const int wid = wave_id, tid = wid * 64 + lane, wr = wid >> 2, wc = wid & 3, fr = lane & 15, fq = lane >> 4;
    const int K = g.K, lda = g.lda, nt = K / BK; constexpr bool ALIGN_EPI = GEMM_ALIGN_EPI;
    unsigned vA[2][2], voffB[2]; LAS int* gtab = (LAS int*)(lds + STAGE_BYTES + 2048);
    const size_t kstep = (size_t)(BK * 2);
    const size_t hstepA = (size_t)HALF * lda * 2, hstepB = (size_t)HALF * K * 2;
    const size_t tstepA = GATHER ? 0 : 2 * hstepA, tstepB = 2 * hstepB;
#pragma unroll
    for (int i = 0; i < 2; ++i) { int R, C; stage_rc(tid * 16 + i * 8192, R, C); const int Rb = Epi::PERM ? ((R & ~31) + perm32(R & 31)) : R;
        vA[0][i] = (unsigned)(R * lda + C) * 2u; vA[1][i] = vA[0][i] + (unsigned)hstepA; voffB[i] = (unsigned)(Rb * K + C) * 2u; }
#define PG8_LOADVA(dst, pm_) do { int t2_ = tid; asm volatile("" : "+v"(t2_)); _Pragma("unroll") for (int i_ = 0; i_ < 2; ++i_) { int R_, C_; stage_rc(t2_ * 16 + i_ * 8192, R_, C_); \
        _Pragma("unroll") for (int h_ = 0; h_ < 2; ++h_) dst[h_][i_] = (unsigned)rowtok[(pm_) * 256 + 128 * h_ + R_] * (unsigned)(lda * 2) + (unsigned)(C_ * 2); } } while (0)
    const unsigned ldsw = (unsigned)wid * 1024u;
    const int aoff = lds_byte(wr * 64 + fr, fq * 8), boff = lds_byte(wc * 32 + fr, fq * 8);
#define PG8_SA(b, h) (((b) * 2 + (h)) * HTB)
#define PG8_SB(b, h) ((4 + (b) * 2 + (h)) * HTB)
#define PG8_STAGE(bufoff, gbase, voff) do { _Pragma("unroll") for (int _i = 0; _i < 2; ++_i) \
        __builtin_amdgcn_global_load_lds((const unsigned*)((const char*)(gbase) + (voff)[_i]), (LAS unsigned*)(lds + (bufoff) + ldsw + _i * 8192), 16, 0, 0); } while (0)
#define PG8_LDA(dst, b, h) do { _Pragma("unroll") for (int m = 0; m < 4; ++m) _Pragma("unroll") for (int k = 0; k < 2; ++k) dst[m][k] = *(const LAS bf16x8*)(lds + PG8_SA(b, h) + aoff + m * 2048 + k * 1024); } while (0)
#define PG8_LDB(dst, b, h) do { _Pragma("unroll") for (int n = 0; n < 2; ++n) _Pragma("unroll") for (int k = 0; k < 2; ++k) dst[n][k] = *(const LAS bf16x8*)(lds + PG8_SB(b, h) + boff + n * 2048 + k * 1024); } while (0)
#define PG8_MMA(ai, bj, At, Bt) do { __builtin_amdgcn_s_setprio(1); _Pragma("unroll") for (int m = 0; m < 4; ++m) _Pragma("unroll") for (int n = 0; n < 2; ++n) _Pragma("unroll") for (int k = 0; k < 2; ++k) \
        acc[ai][bj][m][n] = __builtin_amdgcn_mfma_f32_16x16x32_bf16(Bt[n][k], At[m][k], acc[ai][bj][m][n], 0, 0, 0); __builtin_amdgcn_s_setprio(0); } while (0)
#define PG8_WAIT_V(n) asm volatile("s_waitcnt vmcnt(" #n ")" ::: "memory")
#define PG8_WAIT_L(n) asm volatile("s_waitcnt lgkmcnt(" #n ")" ::: "memory")
#define PG8_BAR __builtin_amdgcn_s_barrier()
#define PG8_SCHED __builtin_amdgcn_sched_barrier(0)
    Unit cur, nxt; int ui = 0;
    if (!S.next(0, cur)) return;
    f32x4 acc[2][2][4][2];
#pragma unroll
    for (int a = 0; a < 2; ++a)
#pragma unroll
        for (int b = 0; b < 2; ++b)
#pragma unroll
            for (int m = 0; m < 4; ++m)
#pragma unroll
                for (int n = 0; n < 2; ++n) acc[a][b][m][n] = (f32x4){0.f, 0.f, 0.f, 0.f};
    bf16x8 At[4][2], B0[2][2], B1[2][2];
    const char* cA = (const char*)g.A + (size_t)cur.pm * tstepA; const char* cB = (const char*)g.Bt + (size_t)cur.pb * tstepB;
    if constexpr (GATHER) { PG8_LOADVA(vA, cur.pm); }
    PG8_STAGE(PG8_SB(0, 0), cB, voffB); PG8_STAGE(PG8_SB(0, 1), cB + hstepB, voffB); PG8_STAGE(PG8_SA(0, 0), cA, vA[0]); PG8_STAGE(PG8_SA(0, 1), cA, vA[1]);
    if (wr == 1) PG8_BAR;
    PG8_WAIT_V(2); PG8_BAR;
    PG8_STAGE(PG8_SB(1, 0), cB + kstep, voffB); PG8_STAGE(PG8_SA(1, 0), cA + kstep, vA[0]); PG8_STAGE(PG8_SB(1, 1), cB + hstepB + kstep, voffB);
    PG8_WAIT_V(6); PG8_BAR;
    for (;;) {
        const bool has_next = S.next(ui + 1, nxt);
        const char* nA = has_next ? (const char*)g.A + (size_t)nxt.pm * tstepA : cA; const char* nB = has_next ? (const char*)g.Bt + (size_t)nxt.pb * tstepB : cB;
        if constexpr (GATHER) { if (has_next && wid < 4)
            __builtin_amdgcn_global_load_lds((const unsigned*)(rowtok + nxt.pm * 256 + tid), (LAS unsigned*)(gtab + wid * 64), 4, 0, 0); }
        for (int t = 0; t < nt; t += 2) {
            const bool last = (t == nt - 2);
            const char* a1 = cA + (size_t)(t + 1) * kstep;
            const char* a2 = last ? nA : cA + (size_t)(t + 2) * kstep; const char* b2 = last ? nB : cB + (size_t)(t + 2) * kstep;
            const char* a3 = a2 + kstep; const char* b3 = b2 + kstep;
            if constexpr (Epi::MIDK) { if (t == Epi::MID_T) { if (ALIGN_EPI && wr == 0) PG8_BAR; int fr2 = fr, fq2 = fq; asm volatile("" : "+v"(fr2), "+v"(fq2)); E.mid(acc, cur, wr, wc, fr2, fq2); if (ALIGN_EPI && wr == 1) PG8_BAR; } }
            PG8_LDB(B0, 0, 0); PG8_LDB(B1, 0, 1); PG8_SCHED; PG8_LDA(At, 0, 0); PG8_STAGE(PG8_SA(1, 1), a1, vA[1]);
            if constexpr (GATHER) { if (last && has_next) { int t2_ = tid; asm volatile("" : "+v"(t2_));
#pragma unroll
                for (int i_ = 0; i_ < 2; ++i_) { int R_, C_; stage_rc(t2_ * 16 + i_ * 8192, R_, C_);
                    vA[0][i_] = (unsigned)gtab[R_] * (unsigned)(lda * 2) + (unsigned)(C_ * 2); vA[1][i_] = (unsigned)gtab[128 + R_] * (unsigned)(lda * 2) + (unsigned)(C_ * 2); } } }
            PG8_WAIT_V(8); PG8_WAIT_L(0); PG8_BAR; PG8_MMA(0, 0, At, B0); PG8_MMA(0, 1, At, B1); PG8_BAR; PG8_SCHED;
            PG8_LDA(At, 0, 1); PG8_STAGE(PG8_SB(0, 0), b2, voffB); PG8_STAGE(PG8_SB(0, 1), b2 + hstepB, voffB); PG8_STAGE(PG8_SA(0, 0), a2, vA[0]);
            PG8_WAIT_V(8); PG8_WAIT_L(0); PG8_BAR; PG8_MMA(1, 0, At, B0); PG8_MMA(1, 1, At, B1); PG8_BAR; PG8_SCHED;
            PG8_LDB(B0, 1, 0); PG8_LDB(B1, 1, 1); PG8_SCHED; PG8_LDA(At, 1, 0); PG8_STAGE(PG8_SA(0, 1), a2, vA[1]);
            PG8_WAIT_V(8); PG8_WAIT_L(0); PG8_BAR; PG8_MMA(0, 0, At, B0); PG8_MMA(0, 1, At, B1); PG8_BAR; PG8_SCHED;
            PG8_LDA(At, 1, 1); PG8_STAGE(PG8_SB(1, 0), b3, voffB); PG8_STAGE(PG8_SB(1, 1), b3 + hstepB, voffB); PG8_STAGE(PG8_SA(1, 0), a3, vA[0]);
            PG8_WAIT_V(8); PG8_WAIT_L(0); PG8_BAR; PG8_MMA(1, 0, At, B0); PG8_MMA(1, 1, At, B1); PG8_BAR; PG8_SCHED;
        }
        if constexpr (ALIGN_EPI) { if (wr == 0) PG8_BAR; }
        { int fr2 = fr, fq2 = fq; asm volatile("" : "+v"(fr2), "+v"(fq2)); E(acc, cur, wr, wc, fr2, fq2); }
        if (!has_next) break;
#pragma unroll
        for (int a = 0; a < 2; ++a)
#pragma unroll
            for (int b = 0; b < 2; ++b)
#pragma unroll
                for (int m = 0; m < 4; ++m)
#pragma unroll
                    for (int n = 0; n < 2; ++n) acc[a][b][m][n] = (f32x4){0.f, 0.f, 0.f, 0.f};
        cur = nxt; cA = nA; cB = nB; ++ui;
        if constexpr (ALIGN_EPI) { if (wr == 1) PG8_BAR; }
    }
    PG8_WAIT_V(0);
    if constexpr (!ALIGN_EPI) { if (wr == 0) PG8_BAR; }
    PG8_BAR;
#undef PG8_LOADVA
#undef PG8_SA
#undef PG8_SB
#undef PG8_STAGE
#undef PG8_LDA
#undef PG8_LDB
#undef PG8_MMA
#undef PG8_WAIT_V
#undef PG8_WAIT_L
#undef PG8_BAR
#undef PG8_SCHED
}

typedef f32x4 Acc[2][2][4][2];
__device__ __forceinline__ u32x4 pack8(const f32x4 a, const f32x4 b) { u32x4 w; w.x = cvt_pk_bf16(a[0], a[1]); w.y = cvt_pk_bf16(a[2], a[3]); w.z = cvt_pk_bf16(b[0], b[1]); w.w = cvt_pk_bf16(b[2], b[3]); return w; }
__device__ __forceinline__ void unpack8(const u32x4 w, f32x4& a, f32x4& b) {
    a[0] = __uint_as_float(w.x << 16); a[1] = __uint_as_float(w.x & 0xffff0000u); a[2] = __uint_as_float(w.y << 16); a[3] = __uint_as_float(w.y & 0xffff0000u);
    b[0] = __uint_as_float(w.z << 16); b[1] = __uint_as_float(w.z & 0xffff0000u); b[2] = __uint_as_float(w.w << 16); b[3] = __uint_as_float(w.w & 0xffff0000u); }

struct EpiProj {
    static constexpr bool PERM = true, MIDK = false; static constexpr int MID_T = 0;
    bf16_t* Q; bf16_t* KV; bf16_t* U; float* GT; bf16_t* RATIO; bf16_t* S1;
    __device__ __forceinline__ void mid(Acc&, const Unit&, int, int, int, int) const {}
    __device__ __forceinline__ void operator()(const Acc& acc, const Unit& u, int wr, int wc, int fr, int fq) const {
        const int row0 = u.pm * BM + wr * 64 + fr, pn = u.pn;
        if (pn < 7) {
            bf16_t* b0; size_t bstep; int ld; float sc = 1.0f; const int lc = wc * 32 + 8 * fq;
            if (pn < 2) { b0 = Q + pn * 256 + lc; bstep = 128; ld = 512; sc = 0.125f * 1.4426950408889634f; }
            else if (pn < 5) { const int gg = wc >> 1, d = (wc & 1) * 32 + 8 * fq; b0 = KV + ((size_t)((2 * (pn - 2)) * 2 + gg) * T_) * 64 + d; bstep = (size_t)2 * T_ * 64; ld = 64; }
            else { b0 = U + (pn - 5) * 256 + lc; bstep = 128; ld = 512; }
#pragma unroll
            for (int ai = 0; ai < 2; ++ai)
#pragma unroll
                for (int m = 0; m < 4; ++m) { bf16_t* rp = b0 + (size_t)(row0 + ai * HALF + m * 16) * ld;
                    *(u32x4*)(rp) = pack8(acc[ai][0][m][0] * sc, acc[ai][0][m][1] * sc); *(u32x4*)(rp + bstep) = pack8(acc[ai][1][m][0] * sc, acc[ai][1][m][1] * sc); }
        } else if (pn < 15) {
#pragma unroll
            for (int ai = 0; ai < 2; ++ai)
#pragma unroll
                for (int m = 0; m < 4; ++m) {
                    f32x4 r0, r1, s0, s1;
#pragma unroll
                    for (int j = 0; j < 4; ++j) {
                        { const float l0 = fminf(fmaxf(acc[ai][0][m][0][j], -30.f), 30.f), l1 = fminf(fmaxf(acc[ai][1][m][0][j], -30.f), 30.f);
                          const float e0 = 1.0f + fexpn(l0), e1 = 1.0f + fexpn(l1); r0[j] = e1 * frcp(e0); s0[j] = frcp(e1); }
                        { const float l0 = fminf(fmaxf(acc[ai][0][m][1][j], -30.f), 30.f), l1 = fminf(fmaxf(acc[ai][1][m][1][j], -30.f), 30.f);
                          const float e0 = 1.0f + fexpn(l0), e1 = 1.0f + fexpn(l1); r1[j] = e1 * frcp(e0); s1[j] = frcp(e1); }
                    }
                    const size_t o = ((((size_t)(u.pm * 8 + pn - 7) * 8 + wr * 4 + wc) * 8 + ai * 4 + m) * 64 + fq * 16 + fr) * 8;
                    *(u32x4*)(RATIO + o) = pack8(r0, r1); *(u32x4*)(S1 + o) = pack8(s0, s1);
                }
        } else {
            if (wc == 0 && fq < 3) {
#pragma unroll
                for (int ai = 0; ai < 2; ++ai)
#pragma unroll
                    for (int m = 0; m < 4; ++m) { f32x4 a, b;
#pragma unroll
                        for (int j = 0; j < 4; ++j) { a[j] = sigmoidf_(acc[ai][0][m][0][j]); b[j] = sigmoidf_(acc[ai][0][m][1][j]); }
                        float* gp = GT + (size_t)(row0 + ai * HALF + m * 16) * 32 + 8 * fq; *(f32x4*)(gp) = a; *(f32x4*)(gp + 4) = b; }
            }
        }
    }
};
struct EpiCmpH {
    static constexpr bool PERM = true, MIDK = false; static constexpr int MID_T = 0;
    bf16_t* HC; const float* bias;
    __device__ __forceinline__ void mid(Acc&, const Unit&, int, int, int, int) const {}
    __device__ __forceinline__ void operator()(const Acc& acc, const Unit& u, int wr, int wc, int fr, int fq) const {
        const int row0 = u.pm * BM + wr * 64 + fr; const float* bp = bias + u.pb * 256;
#pragma unroll
        for (int bj = 0; bj < 2; ++bj) { const int c0 = bj * 128 + wc * 32 + 8 * fq; const f32x4 b0 = *(const f32x4*)(bp + c0), b1 = *(const f32x4*)(bp + c0 + 4);
#pragma unroll
            for (int ai = 0; ai < 2; ++ai)
#pragma unroll
                for (int m = 0; m < 4; ++m) { f32x4 x0 = acc[ai][bj][m][0] + b0, x1 = acc[ai][bj][m][1] + b1;
#pragma unroll
                    for (int j = 0; j < 4; ++j) { const float a = x0[j], b = x1[j];
                        x0[j] = a * frcp(1.0f + fexpn(1.5957691216f * (a + 0.044715f * a * a * a)));
                        x1[j] = b * frcp(1.0f + fexpn(1.5957691216f * (b + 0.044715f * b * b * b))); }
                    *(u32x4*)(HC + (size_t)(row0 + ai * HALF + m * 16) * 256 + c0) = pack8(x0, x1); } }
    }
};
struct EpiMerge {
    static constexpr bool PERM = true, MIDK = true; static constexpr int MID_T = 8;
    const bf16_t* RATIO; const bf16_t* S1; bf16_t* OUT;
    __device__ __forceinline__ size_t gimg(int row0, int col0, int bj) const { const int pm = row0 >> 8, wr = (row0 >> 6) & 1, fr = row0 & 15, pn = col0 >> 8, wc = (col0 >> 5) & 3, fq = (col0 >> 3) & 3;
        return ((((size_t)(pm * 8 + 2 * pn + bj) * 8 + wr * 4 + wc) * 8) * 64 + fq * 16 + fr) * 8; }
    __device__ __forceinline__ void load8(const bf16_t* P, int row0, int col0, int ai, u32x4 (&w)[8]) const {
#pragma unroll
        for (int m = 0; m < 4; ++m)
#pragma unroll
            for (int bj = 0; bj < 2; ++bj) w[m * 2 + bj] = *(const u32x4*)(P + gimg(row0, col0, bj) + (ai * 4 + m) * 512);
        asm volatile("" : "+v"(w[0]), "+v"(w[1]), "+v"(w[2]), "+v"(w[3]), "+v"(w[4]), "+v"(w[5]), "+v"(w[6]), "+v"(w[7]));
    }
    __device__ __forceinline__ void mid(Acc& acc, const Unit& u, int wr, int wc, int fr, int fq) const {
        const int row0 = u.pm * BM + wr * 64 + fr, col0 = u.pn * BM + wc * 32 + 8 * fq;
        u32x4 w0[8], w1[8];
#pragma unroll
        for (int m = 0; m < 4; ++m)
#pragma unroll
            for (int bj = 0; bj < 2; ++bj) { w0[m * 2 + bj] = *(const u32x4*)(RATIO + gimg(row0, col0, bj) + m * 512); w1[m * 2 + bj] = *(const u32x4*)(RATIO + gimg(row0, col0, bj) + (4 + m) * 512); }
        asm volatile("" : "+v"(w0[0]), "+v"(w0[1]), "+v"(w0[2]), "+v"(w0[3]), "+v"(w0[4]), "+v"(w0[5]), "+v"(w0[6]), "+v"(w0[7]));
        asm volatile("" : "+v"(w1[0]), "+v"(w1[1]), "+v"(w1[2]), "+v"(w1[3]), "+v"(w1[4]), "+v"(w1[5]), "+v"(w1[6]), "+v"(w1[7]));
#pragma unroll
        for (int m = 0; m < 4; ++m)
#pragma unroll
            for (int bj = 0; bj < 2; ++bj) { f32x4 a, b; unpack8(w0[m * 2 + bj], a, b); acc[0][bj][m][0] *= a; acc[0][bj][m][1] *= b; unpack8(w1[m * 2 + bj], a, b); acc[1][bj][m][0] *= a; acc[1][bj][m][1] *= b; }
    }
    __device__ __forceinline__ void operator()(const Acc& acc, const Unit& u, int wr, int wc, int fr, int fq) const {
        const int row0 = u.pm * BM + wr * 64 + fr, col0 = u.pn * BM + wc * 32 + 8 * fq;
#pragma unroll
        for (int ai = 0; ai < 2; ++ai) { u32x4 w[8]; load8(S1, row0, col0, ai, w);
#pragma unroll
            for (int m = 0; m < 4; ++m)
#pragma unroll
                for (int bj = 0; bj < 2; ++bj) { const size_t o = (size_t)(row0 + ai * HALF + m * 16) * 1024 + col0 + bj * HALF; f32x4 a, b; unpack8(w[m * 2 + bj], a, b);
                    *(u32x4*)(OUT + o) = pack8(acc[ai][bj][m][0] * a, acc[ai][bj][m][1] * b); } }
    }
};
struct EpiResid {
    static constexpr bool PERM = true, MIDK = false; static constexpr int MID_T = 0;
    const void* hin; bf16_t* hout; bool in_f32;
    __device__ __forceinline__ void mid(Acc&, const Unit&, int, int, int, int) const {}
    __device__ __forceinline__ void operator()(const Acc& acc, const Unit& u, int wr, int wc, int fr, int fq) const {
        const int row0 = u.pm * BM + wr * 64 + fr, col0 = u.pn * BM + wc * 32 + 8 * fq;
        if (in_f32) {
#pragma unroll
            for (int ai = 0; ai < 2; ++ai)
#pragma unroll
                for (int mh = 0; mh < 2; ++mh) { f32x4 w[8];
#pragma unroll
                    for (int m2 = 0; m2 < 2; ++m2)
#pragma unroll
                        for (int bj = 0; bj < 2; ++bj) { const size_t off = (size_t)(row0 + ai * HALF + (mh * 2 + m2) * 16) * 1024 + col0 + bj * HALF; w[(m2 * 2 + bj) * 2] = *(const f32x4*)((const float*)hin + off); w[(m2 * 2 + bj) * 2 + 1] = *(const f32x4*)((const float*)hin + off + 4); }
                    asm volatile("" : "+v"(w[0]), "+v"(w[1]), "+v"(w[2]), "+v"(w[3]), "+v"(w[4]), "+v"(w[5]), "+v"(w[6]), "+v"(w[7]));
#pragma unroll
                    for (int m2 = 0; m2 < 2; ++m2)
#pragma unroll
                        for (int bj = 0; bj < 2; ++bj) { const int m = mh * 2 + m2; const size_t off = (size_t)(row0 + ai * HALF + m * 16) * 1024 + col0 + bj * HALF;
                            *(u32x4*)(hout + off) = pack8(w[(m2 * 2 + bj) * 2] + acc[ai][bj][m][0], w[(m2 * 2 + bj) * 2 + 1] + acc[ai][bj][m][1]); } }
        } else { u32x4 w0[8], w1[8];
            bf16_t* hb = hout + (size_t)row0 * 1024 + col0;
#pragma unroll
            for (int m = 0; m < 4; ++m)
#pragma unroll
                for (int bj = 0; bj < 2; ++bj) { w0[m * 2 + bj] = *(const u32x4*)(hb + (m * 16) * 1024 + bj * HALF); w1[m * 2 + bj] = *(const u32x4*)(hb + (HALF + m * 16) * 1024 + bj * HALF); }
            asm volatile("" : "+v"(w0[0]), "+v"(w0[1]), "+v"(w0[2]), "+v"(w0[3]), "+v"(w0[4]), "+v"(w0[5]), "+v"(w0[6]), "+v"(w0[7]));
            asm volatile("" : "+v"(w1[0]), "+v"(w1[1]), "+v"(w1[2]), "+v"(w1[3]), "+v"(w1[4]), "+v"(w1[5]), "+v"(w1[6]), "+v"(w1[7]));
#pragma unroll
            for (int ai = 0; ai < 2; ++ai)
#pragma unroll
                for (int m = 0; m < 4; ++m)
#pragma unroll
                    for (int bj = 0; bj < 2; ++bj) { f32x4 a, b; unpack8(ai ? w1[m * 2 + bj] : w0[m * 2 + bj], a, b);
                        *(u32x4*)(hb + (ai * HALF + m * 16) * 1024 + bj * HALF) = pack8(a + acc[ai][bj][m][0], b + acc[ai][bj][m][1]); }
        }
    }
};
struct EpiSwiglu {
    static constexpr bool PERM = true, MIDK = false; static constexpr int MID_T = 0;
    bf16_t* H; int ldh;
    __device__ __forceinline__ void mid(Acc&, const Unit&, int, int, int, int) const {}
    __device__ __forceinline__ void operator()(const Acc& acc, const Unit& u, int wr, int wc, int fr, int fq) const {
        const int row0 = u.pm * BM + wr * 64 + fr, col0 = u.pn * 128 + wc * 32 + 8 * fq;
#pragma unroll
        for (int ai = 0; ai < 2; ++ai)
#pragma unroll
            for (int m = 0; m < 4; ++m) { f32x4 x0, x1;
#pragma unroll
                for (int j = 0; j < 4; ++j) { const float g0 = acc[ai][0][m][0][j], g1 = acc[ai][0][m][1][j];
                    x0[j] = g0 * frcp(1.0f + fexpn(g0)) * acc[ai][1][m][0][j]; x1[j] = g1 * frcp(1.0f + fexpn(g1)) * acc[ai][1][m][1][j]; }
                *(u32x4*)(H + (size_t)(row0 + ai * HALF + m * 16) * ldh + col0) = pack8(x0, x1); }
    }
};
struct EpiScatter {
    static constexpr bool PERM = true, MIDK = false; static constexpr int MID_T = 0;
    bf16_t* YB; const int* row_dst;
    __device__ __forceinline__ void mid(Acc&, const Unit&, int, int, int, int) const {}
    __device__ __forceinline__ void operator()(const Acc& acc, const Unit& u, int wr, int wc, int fr, int fq) const {
        const int row0 = u.pm * BM + wr * 64 + fr, col0 = u.pn * BM + wc * 32 + 8 * fq;
        int dst[8];
#pragma unroll
        for (int ai = 0; ai < 2; ++ai)
#pragma unroll
            for (int m = 0; m < 4; ++m) dst[ai * 4 + m] = row_dst[row0 + ai * HALF + m * 16];
        asm volatile("" : "+v"(dst[0]), "+v"(dst[1]), "+v"(dst[2]), "+v"(dst[3]), "+v"(dst[4]), "+v"(dst[5]), "+v"(dst[6]), "+v"(dst[7]));
#pragma unroll
        for (int ai = 0; ai < 2; ++ai)
#pragma unroll
            for (int m = 0; m < 4; ++m) {
#pragma unroll
                for (int bj = 0; bj < 2; ++bj) *(u32x4*)(YB + (size_t)dst[ai * 4 + m] * 1024 + col0 + bj * HALF) = pack8(acc[ai][bj][m][0], acc[ai][bj][m][1]); }
    }
};
}

struct Params {
    const float* x; const float* norm_mix_g; const float* w_in; const float* cmp_pos; const float* cmp_w1; const float* cmp_w2; const float* w_nsa_up;
    const float* pool_w; const float* pool_scale; const float* w_pool_up; const float* w_out; const float* norm_ffn_g;
    const float* ffn_w_gate; const float* ffn_w_up; const float* ffn_w_down; const float* moe_w_router; const float* moe_b_router;
    const float* moe_w_gate; const float* moe_w_up; const float* moe_w_down; const float* final_norm_g;
    float* out; unsigned char* ws;
    int ph_lo, ph_hi;
};

__device__ __forceinline__ void load_params(Params& p) {
#if defined(__HIP_DEVICE_COMPILE__)
    typedef const __attribute__((address_space(4))) unsigned long long* cptr_t;
    typedef __attribute__((address_space(1))) const float* gcf; typedef __attribute__((address_space(1))) float* gf; typedef __attribute__((address_space(1))) unsigned char* guc;
    cptr_t q = (cptr_t)__builtin_amdgcn_kernarg_segment_ptr(); asm volatile("" : "+s"(q));
    p.x = (const float*)(gcf)q[0];
    p.norm_mix_g = (const float*)(gcf)q[1];
    p.w_in = (const float*)(gcf)q[2];
    p.cmp_pos = (const float*)(gcf)q[3];
    p.cmp_w1 = (const float*)(gcf)q[4];
    p.cmp_w2 = (const float*)(gcf)q[5];
    p.w_nsa_up = (const float*)(gcf)q[6];
    p.pool_w = (const float*)(gcf)q[7];
    p.pool_scale = (const float*)(gcf)q[8];
    p.w_pool_up = (const float*)(gcf)q[9];
    p.w_out = (const float*)(gcf)q[10];
    p.norm_ffn_g = (const float*)(gcf)q[11];
    p.ffn_w_gate = (const float*)(gcf)q[12];
    p.ffn_w_up = (const float*)(gcf)q[13];
    p.ffn_w_down = (const float*)(gcf)q[14];
    p.moe_w_router = (const float*)(gcf)q[15];
    p.moe_b_router = (const float*)(gcf)q[16];
    p.moe_w_gate = (const float*)(gcf)q[17];
    p.moe_w_up = (const float*)(gcf)q[18];
    p.moe_w_down = (const float*)(gcf)q[19];
    p.final_norm_g = (const float*)(gcf)q[20];
    p.out = (float*)(gf)q[21]; p.ws = (unsigned char*)(guc)q[22];
    { const unsigned long long w = q[23]; p.ph_lo = (int)(unsigned)w; p.ph_hi = (int)(unsigned)(w >> 32); }
#endif
}
__device__ __forceinline__ unsigned char* launder_ws(unsigned char* w) {
    unsigned long long v = (unsigned long long)w; asm volatile("" : "+s"(v)); return (unsigned char*)(__attribute__((address_space(1))) unsigned char*)v; }
__device__ __forceinline__ XcdBarrier relaunder_bar(const XcdBarrier& b) {
    unsigned long long pb = (unsigned long long)b.bar; unsigned x = b.x; unsigned st = (unsigned)(unsigned long long)(uintptr_t)b.st;
    asm volatile("" : "+s"(pb), "+s"(x), "+s"(st));
    XcdBarrier r; r.bar = (unsigned*)(__attribute__((address_space(1))) unsigned*)pb; r.x = x; r.st = (volatile LAS unsigned*)(uintptr_t)st; return r; }
constexpr int NTHR = 512, NWAVES = 8;
constexpr int RING_BYTES = 131072, MISC_OFF = RING_BYTES, LDS_BYTES = 147456;

struct Ctx { LAS unsigned char* lds; int tid, lane, wave, G, bid; };

__device__ __forceinline__ void tconv_tile(const Ctx& F, const float* src, int ld, int col0, int nvalid, int k0, bf16_t* dst, int ldd, int r0, int kd0) {
    LAS float* tile = (LAS float*)(F.lds + F.wave * 8704);
    const int lane = F.lane, kq = lane >> 3, c4 = (lane & 7) * 4;
    f32x4 v[8];
#pragma unroll
    for (int i = 0; i < 8; ++i) { const float* sp = src + (size_t)(k0 + kq + 8 * i) * ld + col0 + c4;
        if (c4 + 3 < nvalid) v[i] = *(const f32x4*)sp;
        else { v[i][0] = (c4 < nvalid) ? sp[0] : 0.f; v[i][1] = (c4 + 1 < nvalid) ? sp[1] : 0.f; v[i][2] = (c4 + 2 < nvalid) ? sp[2] : 0.f; v[i][3] = 0.f; } }
    LDS_FENCE();
#pragma unroll
    for (int i = 0; i < 8; ++i)
#pragma unroll
        for (int j = 0; j < 4; ++j) tile[(c4 + j) * 68 + kq + 8 * i] = v[i][j];
    LDS_FENCE();
    { const int c = lane >> 1, kh = (lane & 1) * 32; u32x4 w[4];
#pragma unroll
      for (int q = 0; q < 4; ++q) { const f32x4 a = *(const LAS f32x4*)(tile + c * 68 + kh + q * 8), b = *(const LAS f32x4*)(tile + c * 68 + kh + q * 8 + 4); w[q] = pg8::pack8(a, b); }
      bf16_t* dp = dst + (size_t)(r0 + c) * ldd + kd0 + k0 + kh;
#pragma unroll
      for (int q = 0; q < 4; ++q) *(u32x4*)(dp + q * 8) = w[q]; }
}
template <class Fn>
__device__ __forceinline__ void tconv_matrix(const Ctx& F, int nrow_tiles, int K, bf16_t* dst, int ldd, int kd0, int& wcur, Fn fn) {
    const int nk = K / 64, ntiles = nrow_tiles * nk, NW = F.G * NWAVES, me = F.bid * NWAVES + F.wave;
    int first = (me - (wcur % NW) + NW) % NW;
    for (int i = first; i < ntiles; i += NW) { const int rt = i % nrow_tiles, kt = i / nrow_tiles;   const float* src; int ld, col0, nvalid; fn(rt, src, ld, col0, nvalid);
        tconv_tile(F, src, ld, col0, nvalid, kt * 64, dst, ldd, rt * 32, kd0); }
    wcur += ntiles;
}

__device__ __forceinline__ void phase_prep_mixer(const Ctx& F, const Params& p, int L, int part = 3) {
    unsigned char* ws = p.ws; int wcur = 0;
    if (part & 1) {
    { const float* base = p.w_in + (size_t)L * 1024 * INC_;
      tconv_matrix(F, 128, 1024, (bf16_t*)(ws + W_IN_(L)), 1024, 0, wcur, [&](int rt, const float*& src, int& ld, int& col0, int& nvalid) {
          const int r0 = rt * 32; src = base; ld = INC_; nvalid = 32;
          if (r0 < 1280) col0 = r0;
          else if (r0 < 1792) col0 = 1304 + (r0 - 1280);
          else if (r0 < 3840) { const int loc = r0 - 1792, q8 = loc >> 8, within = loc & 255, half = within >> 7, i = within & 127; col0 = 1816 + half * 1024 + q8 * 128 + i; }
          else if (r0 == 3840) { col0 = 1280; nvalid = 24; }
          else { col0 = 0; nvalid = 0; } }); }
    { const float* base = p.cmp_w1 + (size_t)L * 2 * 2048 * 256;
      tconv_matrix(F, 16, 2048, (bf16_t*)(ws + W_C1_(L)), 2048, 0, wcur, [&](int rt, const float*& src, int& ld, int& col0, int& nvalid) {
          src = base + (size_t)(rt >> 3) * 2048 * 256; ld = 256; col0 = (rt & 7) * 32; nvalid = 32; }); }
    { const float* base = p.w_nsa_up + (size_t)L * 512 * 1024;
      tconv_matrix(F, 32, 512, (bf16_t*)(ws + W_M_(L)), 1024, 0, wcur, [&](int rt, const float*& src, int& ld, int& col0, int& nvalid) { src = base; ld = 1024; col0 = rt * 32; nvalid = 32; }); }
    { const float* base = p.w_out + (size_t)L * 1024 * 1024;
      tconv_matrix(F, 32, 1024, (bf16_t*)(ws + W_O_(L)), 1024, 0, wcur, [&](int rt, const float*& src, int& ld, int& col0, int& nvalid) { src = base; ld = 1024; col0 = rt * 32; nvalid = 32; }); }
    }
    if (!(part & 2)) return;
    if (F.bid >= F.G - 16) { const int wq = F.bid - (F.G - 16), kv = wq >> 3, cb = (wq & 7) * 32, c = F.tid & 31, kg = F.tid >> 5;
        const float* pos = p.cmp_pos + (size_t)(L * 2 + kv) * 2048; const float* w1 = p.cmp_w1 + (size_t)(L * 2 + kv) * 2048 * 256 + cb + c; float s = 0.f;
#pragma unroll 32
        for (int j = 0; j < 128; ++j) { const int k = kg + 16 * j; s += pos[k] * w1[(size_t)k * 256]; }
        LAS float* red = (LAS float*)(F.lds + 73728); red[F.tid] = s; __syncthreads();
        if (F.tid < 32) { float t = 0.f;
#pragma unroll
            for (int q = 0; q < 16; ++q) t += red[q * 32 + F.tid];
            ((float*)(ws + W_B1_(L)))[kv * 256 + cb + F.tid] = t; }
        __syncthreads(); }
    if (F.bid < 64) { const int g = F.bid >> 4, c0 = (F.bid & 15) * 8; const float* pw = p.pool_w + (size_t)L * 4 * 128 * 128 + (size_t)(g * 128 + c0) * 128; const float* ps = p.pool_scale + (size_t)L * 512 + g * 128;
        const float* wp = p.w_pool_up + (size_t)L * 512 * 1024 + (size_t)(g * 128) * 1024 + F.tid * 2; bf16_t* wm = (bf16_t*)(ws + W_M_(L));
        LAS float* al = (LAS float*)(F.lds + 73728);
        for (int i = F.tid; i < 1024; i += NTHR) { const int d = i >> 3, cc = i & 7; al[i] = pw[cc * 128 + d] * ps[d]; }
        __syncthreads();
        f32x2 acc[8];
#pragma unroll
        for (int cc = 0; cc < 8; ++cc) acc[cc] = (f32x2){0.f, 0.f};
#pragma unroll 16
        for (int d = 0; d < 128; ++d) { const f32x2 w = *(const f32x2*)(wp + (size_t)d * 1024); const f32x4 a0 = *(const LAS f32x4*)(al + d * 8), a1 = *(const LAS f32x4*)(al + d * 8 + 4);
            acc[0] += w * a0[0]; acc[1] += w * a0[1]; acc[2] += w * a0[2]; acc[3] += w * a0[3]; acc[4] += w * a1[0]; acc[5] += w * a1[1]; acc[6] += w * a1[2]; acc[7] += w * a1[3]; }
#pragma unroll
        for (int i = 0; i < 2; ++i) { u32x4 o; o.x = cvt_pk_bf16(acc[0][i], acc[1][i]); o.y = cvt_pk_bf16(acc[2][i], acc[3][i]); o.z = cvt_pk_bf16(acc[4][i], acc[5][i]); o.w = cvt_pk_bf16(acc[6][i], acc[7][i]);
            *(u32x4*)(wm + (size_t)(F.tid * 2 + i) * 1024 + 512 + g * 128 + c0) = o; }
        __syncthreads(); }
}

__device__ __forceinline__ void phase_prep_ffn(const Ctx& F, const Params& p, int L) {
    unsigned char* ws = p.ws; int wcur = 0;
    const int j = L >> 1;
    if ((L & 1) == 0) {
        const float* wg = p.ffn_w_gate + (size_t)j * 1024 * DFF_; const float* wu = p.ffn_w_up + (size_t)j * 1024 * DFF_; const float* wd = p.ffn_w_down + (size_t)j * DFF_ * 1024;
        tconv_matrix(F, 2 * DFF_ / 32, 1024, (bf16_t*)(ws + W_FF), 1024, 0, wcur, [&](int rt, const float*& src, int& ld, int& col0, int& nvalid) {
            const int r0 = rt * 32, pn = r0 >> 8, within = r0 & 255, half = within >> 7, i = within & 127; src = half ? wu : wg; ld = DFF_; col0 = pn * 128 + i; nvalid = 32; });
        tconv_matrix(F, 32, DFF_, (bf16_t*)(ws + W_FFD_DENSE), DFF_, 0, wcur, [&](int rt, const float*& src, int& ld, int& col0, int& nvalid) { src = wd; ld = 1024; col0 = rt * 32; nvalid = 32; });
    } else {
        const float* wg = p.moe_w_gate + (size_t)j * NE_ * 1024 * DFE_; const float* wu = p.moe_w_up + (size_t)j * NE_ * 1024 * DFE_; const float* wd = p.moe_w_down + (size_t)j * NE_ * DFE_ * 1024;
        constexpr int RT_E = 2 * DFE_ / 32;
        tconv_matrix(F, NE_ * RT_E, 1024, (bf16_t*)(ws + W_FF), 1024, 0, wcur, [&](int rt, const float*& src, int& ld, int& col0, int& nvalid) {
            const int e = rt / RT_E, r0 = (rt % RT_E) * 32, pn = r0 >> 8, within = r0 & 255, half = within >> 7, i = within & 127;
            src = (half ? wu : wg) + (size_t)e * 1024 * DFE_; ld = DFE_; col0 = pn * 128 + i; nvalid = 32; });
        tconv_matrix(F, NE_ * 32, DFE_, (bf16_t*)(ws + W_FFD_MOE), DFE_, 0, wcur, [&](int rt, const float*& src, int& ld, int& col0, int& nvalid) {
            const int e = rt >> 5; src = wd + (size_t)e * DFE_ * 1024; ld = 1024; col0 = (rt & 31) * 32; nvalid = 32; });
    }
}

__device__ __forceinline__ void phase_norm_b8(const Ctx& F, const bf16_t* h, const float* g, bf16_t* dst) {
    f32x4 gv[4];
#pragma unroll
    for (int i = 0; i < 2; ++i) { gv[2 * i] = *(const f32x4*)(g + i * 512 + F.lane * 8); gv[2 * i + 1] = *(const f32x4*)(g + i * 512 + F.lane * 8 + 4); }
    u32x4 nx[2]; { const int row = F.bid * NWAVES + F.wave; if (row < T_) {
#pragma unroll
        for (int i = 0; i < 2; ++i) nx[i] = *(const u32x4*)(h + (size_t)row * 1024 + i * 512 + F.lane * 8); } }
    for (int row = F.bid * NWAVES + F.wave; row < T_; row += F.G * NWAVES) {
        f32x4 v[4]; float ss = 0.f;
#pragma unroll
        for (int i = 0; i < 2; ++i) pg8::unpack8(nx[i], v[2 * i], v[2 * i + 1]);
        { const int nrow = row + F.G * NWAVES; if (nrow < T_) {
#pragma unroll
            for (int i = 0; i < 2; ++i) nx[i] = *(const u32x4*)(h + (size_t)nrow * 1024 + i * 512 + F.lane * 8); } }
#pragma unroll
        for (int i = 0; i < 4; ++i) ss += v[i][0] * v[i][0] + v[i][1] * v[i][1] + v[i][2] * v[i][2] + v[i][3] * v[i][3];
        ss = wave_sum(ss); const float r = rsqrtf(ss * (1.0f / 1024.0f) + 1e-6f);
#pragma unroll
        for (int i = 0; i < 2; ++i) *(u32x4*)(dst + (size_t)row * 1024 + i * 512 + F.lane * 8) = pg8::pack8(v[2 * i] * r * gv[2 * i], v[2 * i + 1] * r * gv[2 * i + 1]);
    }
}
template <bool HBF> __device__ __forceinline__ f32x4 ld_h4(const void* h, size_t off) {
    if (HBF) { const u32x2 w = *(const u32x2*)((const bf16_t*)h + off); f32x4 v; v[0] = __uint_as_float(w.x << 16); v[1] = __uint_as_float(w.x & 0xffff0000u); v[2] = __uint_as_float(w.y << 16); v[3] = __uint_as_float(w.y & 0xffff0000u); return v; }
    else return *(const f32x4*)((const float*)h + off);
}
template <bool ROUTER, bool HBF>
__device__ __forceinline__ void phase_norm(const Ctx& F, const void* h, const float* g, bf16_t* dst, const float* wrt, const float* brt, int* cnt, int* tok_e, int* tok_p, float* tok_g, int* row_tok, int* row_dst) {
    LAS float* wl = (LAS float*)F.lds;
    LAS int* lcnt = (LAS int*)(F.lds + 32768);
    if (ROUTER) {
        if (F.tid < 8) lcnt[F.tid] = 0;
        for (int i = F.tid; i < 8192; i += NTHR) { const int c = i >> 3, e = i & 7; wl[((((c >> 8) * 4 + (c & 3)) * 2 + (e >> 2)) * 64 + ((c >> 2) & 63)) * 4 + (e & 3)] = wrt[i]; }
        for (int i = F.bid * NTHR + F.tid; i < MOE_ROWS; i += F.G * NTHR) { row_tok[i] = 0; row_dst[i] = YB_DUMMY; }
        __syncthreads();
    }
    f32x4 gv[4];
#pragma unroll
    for (int i = 0; i < 4; ++i) gv[i] = *(const f32x4*)(g + i * 256 + F.lane * 4);
    const bool blk = ROUTER && (T_ % (F.G * NWAVES) == 0); const int rpw = T_ / (F.G * NWAVES);
    const int rstep = blk ? 1 : F.G * NWAVES, rbeg = blk ? (F.bid * NWAVES + F.wave) * rpw : F.bid * NWAVES + F.wave, rend = blk ? rbeg + rpw : T_;
    f32x4 vnx[4]; { const int row = rbeg; if (row < rend) {
#pragma unroll
        for (int i = 0; i < 4; ++i) vnx[i] = ld_h4<HBF>(h, (size_t)row * 1024 + i * 256 + F.lane * 4); } }
    for (int row = rbeg; row < rend; row += rstep) {
        f32x4 v[4]; float ss = 0.f;
#pragma unroll
        for (int i = 0; i < 4; ++i) v[i] = vnx[i];
        { const int nrow = row + rstep; if (nrow < rend) {
#pragma unroll
            for (int i = 0; i < 4; ++i) vnx[i] = ld_h4<HBF>(h, (size_t)nrow * 1024 + i * 256 + F.lane * 4); } }
#pragma unroll
        for (int i = 0; i < 4; ++i) ss += v[i][0] * v[i][0] + v[i][1] * v[i][1] + v[i][2] * v[i][2] + v[i][3] * v[i][3];
        ss = wave_sum(ss); const float r = rsqrtf(ss * (1.0f / 1024.0f) + 1e-6f);
#pragma unroll
        for (int i = 0; i < 4; ++i) { v[i] = v[i] * r * gv[i]; u32x2 w; w.x = cvt_pk_bf16(v[i][0], v[i][1]); w.y = cvt_pk_bf16(v[i][2], v[i][3]); *(u32x2*)(dst + (size_t)row * 1024 + i * 256 + F.lane * 4) = w; }
        if (ROUTER) {
            f32x2 lgp[4];
#pragma unroll
            for (int e = 0; e < 4; ++e) lgp[e] = (f32x2){0.f, 0.f};
#pragma unroll
            for (int i = 0; i < 4; ++i)
#pragma unroll
                for (int j = 0; j < 4; ++j) { const LAS float* wp = wl + (((i * 4 + j) * 2) * 64 + F.lane) * 4; const f32x4 w0 = *(const LAS f32x4*)(wp), w1 = *(const LAS f32x4*)(wp + 256); const f32x2 f = {v[i][j], v[i][j]};
                    lgp[0] += f * (f32x2){w0[0], w0[1]}; lgp[1] += f * (f32x2){w0[2], w0[3]}; lgp[2] += f * (f32x2){w1[0], w1[1]}; lgp[3] += f * (f32x2){w1[2], w1[3]}; }
            float lg[8];
#pragma unroll
            for (int e = 0; e < 8; ++e) lg[e] = wave_sum(lgp[e >> 1][e & 1]) + brt[e];
            if (F.lane == 0) {
                int e0 = 0; float b0 = lg[0];
#pragma unroll
                for (int e = 1; e < 8; ++e) if (lg[e] > b0) { b0 = lg[e]; e0 = e; }
                int e1 = -1; float b1 = -3.0e38f;
#pragma unroll
                for (int e = 0; e < 8; ++e) if (e != e0 && lg[e] > b1) { b1 = lg[e]; e1 = e; }
                const float g0 = 1.0f / (1.0f + __expf(b1 - b0)), g1 = 1.0f - g0;
                const int p0 = __hip_atomic_fetch_add(&lcnt[e0], 1, __ATOMIC_RELAXED, __HIP_MEMORY_SCOPE_WORKGROUP), p1 = __hip_atomic_fetch_add(&lcnt[e1], 1, __ATOMIC_RELAXED, __HIP_MEMORY_SCOPE_WORKGROUP);
                tok_e[row * 2] = e0; tok_e[row * 2 + 1] = e1; tok_p[row * 2] = p0; tok_p[row * 2 + 1] = p1; tok_g[row * 2] = g0; tok_g[row * 2 + 1] = g1;
            }
        }
    }
    if (ROUTER) { __syncthreads(); if (F.tid < 8) cnt[F.bid * 8 + F.tid] = lcnt[F.tid]; }
}

__device__ __forceinline__ void phase_final_norm(const Ctx& F, float* h, const float* g) {
    f32x4 gv[4];
#pragma unroll
    for (int i = 0; i < 4; ++i) gv[i] = *(const f32x4*)(g + i * 256 + F.lane * 4);
    for (int row = F.bid * NWAVES + F.wave; row < T_; row += F.G * NWAVES) {
        float* hr = h + (size_t)row * 1024; f32x4 v[4]; float ss = 0.f;
#pragma unroll
        for (int i = 0; i < 4; ++i) { v[i] = *(const f32x4*)(hr + i * 256 + F.lane * 4); ss += v[i][0] * v[i][0] + v[i][1] * v[i][1] + v[i][2] * v[i][2] + v[i][3] * v[i][3]; }
        ss = wave_sum(ss); const float r = rsqrtf(ss * (1.0f / 1024.0f) + 1e-6f);
#pragma unroll
        for (int i = 0; i < 4; ++i) *(f32x4*)(hr + i * 256 + F.lane * 4) = v[i] * r * gv[i];
    }
}

__device__ __forceinline__ void phase_pool(const Ctx& F, const bf16_t* U, bf16_t* OP) {
    for (int idx = F.bid * NTHR + F.tid; idx < T_; idx += F.G * NTHR) {
        const int seg = idx >> 6, c8 = (idx & 63) * 8, grp = c8 >> 7, w = 2 << grp, t0 = seg * 64, tt0 = t0 & (S_ - 1);
        const bf16_t* up = U + (size_t)t0 * 512 + c8; bf16_t* op = OP + (size_t)t0 * 1024 + 512 + c8;
        f32x4 s0 = (f32x4){0.f, 0.f, 0.f, 0.f}, s1 = s0;
        if (tt0 > 0) { u32x4 pv[16];
#pragma unroll
            for (int i = 1; i <= 16; ++i) { const int off = ((i <= w) ? i : 1) * 512; pv[i - 1] = *(const u32x4*)(up - off); }
#pragma unroll
            for (int i = 1; i <= 16; ++i) if (i <= w) { f32x4 a, b; pg8::unpack8(pv[i - 1], a, b); s0 += a; s1 += b; } }
#pragma unroll 1
        for (int tb = 0; tb < 64; tb += 8) { u32x4 nv[8], ov[8];
#pragma unroll
            for (int j = 0; j < 8; ++j) { const int t = tb + j; nv[j] = *(const u32x4*)(up + (size_t)t * 512); const int tt = tt0 + t; const int oo = ((tt >= w) ? t - w : t) * 512; ov[j] = *(const u32x4*)(up + oo); }
#pragma unroll
            for (int j = 0; j < 8; ++j) { const int t = tb + j, tt = tt0 + t; f32x4 a, b; pg8::unpack8(nv[j], a, b); s0 += a; s1 += b;
                if (tt >= w) { f32x4 oa, ob; pg8::unpack8(ov[j], oa, ob); s0 -= oa; s1 -= ob; }
                const float inv = 1.0f / (float)((tt + 1 < w) ? tt + 1 : w);
                *(u32x4*)(op + (size_t)t * 1024) = pg8::pack8(s0 * inv - a, s1 * inv - b); } }
    }
}

__device__ __forceinline__ void phase_cmp2(const Ctx& F, const bf16_t* HC, const float* w2  , bf16_t* KC, int blk0, int blk1, int bstep) {
    LAS float* wl = (LAS float*)F.lds;
    LAS float* hl = (LAS float*)(F.lds + 65536) + F.wave * 2048;
    int kv_loaded = -1;
    for (int blk = blk0; blk < blk1; blk += bstep) {
        const int kv = blk >> 7;
        if (kv != kv_loaded) { __syncthreads(); for (int i = F.tid; i < 256 * 64 / 4; i += NTHR) *(LAS f32x4*)(wl + i * 4) = *(const f32x4*)(w2 + (size_t)kv * 256 * 64 + i * 4); kv_loaded = kv; __syncthreads(); }
        const int row0 = blk * 64 + F.wave * 8;
        LDS_FENCE();
#pragma unroll
        for (int r = 0; r < 8; ++r) { const u32x2 wv = *(const u32x2*)(HC + (size_t)(row0 + r) * 256 + F.lane * 4);
            hl[(F.lane * 4 + 0) * 8 + r] = __uint_as_float(wv.x << 16); hl[(F.lane * 4 + 1) * 8 + r] = __uint_as_float(wv.x & 0xffff0000u);
            hl[(F.lane * 4 + 2) * 8 + r] = __uint_as_float(wv.y << 16); hl[(F.lane * 4 + 3) * 8 + r] = __uint_as_float(wv.y & 0xffff0000u); }
        LDS_FENCE();
        float acc[8];
#pragma unroll
        for (int r = 0; r < 8; ++r) acc[r] = 0.f;
#pragma unroll 4
        for (int c = 0; c < 256; ++c) { const float w = wl[c * 64 + F.lane]; const f32x4 h0 = *(const LAS f32x4*)(hl + c * 8), h1 = *(const LAS f32x4*)(hl + c * 8 + 4);
            acc[0] += h0[0] * w; acc[1] += h0[1] * w; acc[2] += h0[2] * w; acc[3] += h0[3] * w; acc[4] += h1[0] * w; acc[5] += h1[1] * w; acc[6] += h1[2] * w; acc[7] += h1[3] * w; }
#pragma unroll
        for (int r = 0; r < 8; ++r) KC[(size_t)(row0 + r) * 64 + F.lane] = f2bf(acc[r]);
    }
}

__device__ __forceinline__ void dot4_row(const bf16_t* krow, const LAS float* qf, float (&s)[4]) {
    s[0] = s[1] = s[2] = s[3] = 0.f;
    u32x4 kr[8];
#pragma unroll
    for (int c = 0; c < 8; ++c) kr[c] = *(const u32x4*)(krow + c * 8);
#pragma unroll
    for (int c = 0; c < 8; ++c) { const u32x4 wv = kr[c]; f32x4 a, b; pg8::unpack8(wv, a, b); asm volatile("" ::: "memory");
#pragma unroll
        for (int i = 0; i < 4; ++i) { const f32x4 q0 = *(const LAS f32x4*)(qf + (c * 8 + i) * 4), q1 = *(const LAS f32x4*)(qf + (c * 8 + 4 + i) * 4);
            s[0] += a[i] * q0[0]; s[1] += a[i] * q0[1]; s[2] += a[i] * q0[2]; s[3] += a[i] * q0[3];
            s[0] += b[i] * q1[0]; s[1] += b[i] * q1[1]; s[2] += b[i] * q1[2]; s[3] += b[i] * q1[3]; } }
}
__device__ __forceinline__ void softmax4(LAS float* sc, int nkeys, int lane) {
    float m[4] = {-3.0e38f, -3.0e38f, -3.0e38f, -3.0e38f};
    for (int n = lane; n < nkeys; n += 64) { const f32x4 v = *(const LAS f32x4*)(sc + n * 4); m[0] = fmaxf(m[0], v[0]); m[1] = fmaxf(m[1], v[1]); m[2] = fmaxf(m[2], v[2]); m[3] = fmaxf(m[3], v[3]); }
#pragma unroll
    for (int h = 0; h < 4; ++h) m[h] = wave_max(m[h]);
    float l[4] = {0.f, 0.f, 0.f, 0.f};
    for (int n = lane; n < nkeys; n += 64) { f32x4 v = *(const LAS f32x4*)(sc + n * 4);
#pragma unroll
        for (int h = 0; h < 4; ++h) { v[h] = __expf(v[h] - m[h]); l[h] += v[h]; }
        *(LAS f32x4*)(sc + n * 4) = v; }
#pragma unroll
    for (int h = 0; h < 4; ++h) l[h] = 1.0f / wave_sum(l[h]);
    for (int n = lane; n < nkeys; n += 64) { f32x4 v = *(const LAS f32x4*)(sc + n * 4); v[0] *= l[0]; v[1] *= l[1]; v[2] *= l[2]; v[3] *= l[3]; *(LAS f32x4*)(sc + n * 4) = v; }
    LDS_FENCE();
}

__device__ __forceinline__ void phase_attn_naive(const Ctx& F, const bf16_t* Q, const bf16_t* KV, const bf16_t* KC, const float* GT, bf16_t* OP) {
    LAS float* qf = (LAS float*)(F.lds + F.wave * 16384);
    LAS float* sc = qf + 256;
    const int lane = F.lane;
    for (int unit = F.bid * NWAVES + F.wave; unit < T_ * 2; unit += F.G * NWAVES) {
        const int tt = unit & (S_ - 1), bg = unit >> 11, g = bg & 1, b = bg >> 1; const size_t t = (size_t)b * S_ + tt;
        LDS_FENCE();
#pragma unroll
        for (int h = 0; h < 4; ++h) qf[lane * 4 + h] = bf2f(Q[t * 512 + (g * 4 + h) * 64 + lane]);
        LDS_FENCE();
        const bf16_t* kc = KC + ((size_t)(0 * 2 + g) * 4096 + b * 128) * 64; const bf16_t* vc = KC + ((size_t)(1 * 2 + g) * 4096 + b * 128) * 64;
        const bf16_t* ks = KV + ((size_t)(2 * 2 + g) * T_ + (size_t)b * S_) * 64; const bf16_t* vs = KV + ((size_t)(3 * 2 + g) * T_ + (size_t)b * S_) * 64;
        const bf16_t* kw = KV + ((size_t)(4 * 2 + g) * T_ + (size_t)b * S_) * 64; const bf16_t* vw = KV + ((size_t)(5 * 2 + g) * T_ + (size_t)b * S_) * 64;
        int ncv = (tt >= 31) ? ((tt - 31) >> 4) + 1 : 0; if (ncv > 127) ncv = 127;
        float ocmp[4] = {0.f, 0.f, 0.f, 0.f}; float imp = 0.f;
        if (ncv > 0) {
#pragma unroll 1
            for (int n0 = 0; n0 < 128; n0 += 64) { const int n = n0 + lane; float s[4]; dot4_row(kc + (size_t)(n < 127 ? n : 126) * 64, qf, s);
                f32x4 v; const bool ok = n < ncv; v[0] = ok ? s[0] : -INFINITY; v[1] = ok ? s[1] : -INFINITY; v[2] = ok ? s[2] : -INFINITY; v[3] = ok ? s[3] : -INFINITY; *(LAS f32x4*)(sc + n * 4) = v; }
            LDS_FENCE();
            softmax4(sc, 128, lane);
            if (lane < 32) { const int nlo = (4 * lane - 1 < 0) ? 0 : 4 * lane - 1, nhi = (4 * lane + 3 > 126) ? 126 : 4 * lane + 3;
                for (int n = nlo; n <= nhi; ++n) { const f32x4 v = *(const LAS f32x4*)(sc + n * 4); imp += (v[0] + v[1]) + (v[2] + v[3]); } }
#pragma unroll 4
            for (int n = 0; n < ncv; ++n) { const f32x4 pv = *(const LAS f32x4*)(sc + n * 4); const float v = bf2f(vc[(size_t)n * 64 + lane]);
                ocmp[0] += pv[0] * v; ocmp[1] += pv[1] * v; ocmp[2] += pv[2] * v; ocmp[3] += pv[3] * v; }
        }
        const int cur = tt >> 6; unsigned selmask = 0u;
        { float val = -3.0e38f; if (lane < 32) { val = imp; if (lane > cur) val = -1.0e9f; if (lane == 0 || lane == cur) val = 1.0e9f; }
          for (int it = 0; it < 8; ++it) { float bv = val; int bi = lane;
#pragma unroll
              for (int o = 32; o >= 1; o >>= 1) { const float ov = __shfl_xor(bv, o); const int oi = __shfl_xor(bi, o); if (ov > bv || (ov == bv && oi < bi)) { bv = ov; bi = oi; } }
              selmask |= 1u << (bi & 31); if (lane == bi) val = -INFINITY; } }
        float osel[4] = {0.f, 0.f, 0.f, 0.f};
        { LDS_FENCE(); unsigned mk = selmask;
#pragma unroll 1
          for (int k = 0; k < 8; ++k) { const int j = __builtin_ctz(mk); mk &= mk - 1u; const int kpos = 64 * j + lane; float s[4]; dot4_row(ks + (size_t)kpos * 64, qf, s);
              const bool ok = kpos <= tt; f32x4 v; v[0] = ok ? s[0] : -INFINITY; v[1] = ok ? s[1] : -INFINITY; v[2] = ok ? s[2] : -INFINITY; v[3] = ok ? s[3] : -INFINITY; *(LAS f32x4*)(sc + (k * 64 + lane) * 4) = v; }
          LDS_FENCE();
          softmax4(sc, 512, lane);
          mk = selmask;
#pragma unroll 1
          for (int k = 0; k < 8; ++k) { const int j = __builtin_ctz(mk); mk &= mk - 1u; if (j > cur) continue; const bf16_t* vb = vs + (size_t)j * 64 * 64;
#pragma unroll 4
              for (int i = 0; i < 64; ++i) { const f32x4 pv = *(const LAS f32x4*)(sc + (k * 64 + i) * 4); const float v = bf2f(vb[(size_t)i * 64 + lane]);
                  osel[0] += pv[0] * v; osel[1] += pv[1] * v; osel[2] += pv[2] * v; osel[3] += pv[3] * v; } } }
        float owin[4] = {0.f, 0.f, 0.f, 0.f};
        { LDS_FENCE();
#pragma unroll 1
          for (int k = 0; k < 8; ++k) { const int kpos = tt - 511 + 64 * k + lane; const bool ok = kpos >= 0; float s[4]; dot4_row(kw + (size_t)(ok ? kpos : 0) * 64, qf, s);
              f32x4 v; v[0] = ok ? s[0] : -INFINITY; v[1] = ok ? s[1] : -INFINITY; v[2] = ok ? s[2] : -INFINITY; v[3] = ok ? s[3] : -INFINITY; *(LAS f32x4*)(sc + (k * 64 + lane) * 4) = v; }
          LDS_FENCE();
          softmax4(sc, 512, lane);
          const int k0 = (tt >= 511) ? 0 : 511 - tt;
#pragma unroll 4
          for (int i = k0; i < 512; ++i) { const f32x4 pv = *(const LAS f32x4*)(sc + i * 4); const float v = bf2f(vw[(size_t)(tt - 511 + i) * 64 + lane]);
              owin[0] += pv[0] * v; owin[1] += pv[1] * v; owin[2] += pv[2] * v; owin[3] += pv[3] * v; } }
        const float* gt = GT + t * 32 + g * 12;
#pragma unroll
        for (int h = 0; h < 4; ++h) { const float o = gt[h * 3] * ocmp[h] + gt[h * 3 + 1] * osel[h] + gt[h * 3 + 2] * owin[h]; OP[t * 1024 + (g * 4 + h) * 64 + lane] = f2bf(o); }
    }
}

namespace att {
typedef float f32x16 __attribute__((ext_vector_type(16)));
typedef short s16x4 __attribute__((ext_vector_type(4)));
constexpr float C2 = 1.4426950408889634f, NEG = -1.0e30f, THR = 8.0f;
constexpr int KSTR = 128;
__device__ __forceinline__ int koff(int row, int ch) { return row * 128 + ((ch ^ ((row >> 1) & 7)) << 4); }
constexpr int L_KB0 = 0, L_KB1 = 9216, L_VB0 = 18432, L_VB1 = 26624, L_WSF = 34816, L_SELM = 36864, L_GT = 37888, L_IMPA = 40960, L_IMPB = L_IMPA + 4 * 64 * 33 * 4, L_STG = L_IMPA, L_KB2 = L_IMPB + 4 * 64 * 33 * 4, L_VB2 = L_KB2 + 9216;
#define MFMA32(a, b, c) __builtin_amdgcn_mfma_f32_32x32x16_bf16(a, b, c, 0, 0, 0)
__device__ __forceinline__ int crow(int r, int hi) { return (r & 3) + 8 * (r >> 2) + 4 * hi; }
__device__ __forceinline__ s16x4 vtr(const LAS char* p) { return __builtin_bit_cast(s16x4, __builtin_amdgcn_ds_read_tr16_b64_v4i16((LAS s16x4*)p)); }
__device__ __forceinline__ float halfswap_sum(float x) { auto rr = __builtin_amdgcn_permlane32_swap(__float_as_uint(x), __float_as_uint(x), false, false); return __uint_as_float(rr[0]) + __uint_as_float(rr[1]); }
__device__ __forceinline__ float halfswap_max(float x) { auto rr = __builtin_amdgcn_permlane32_swap(__float_as_uint(x), __float_as_uint(x), false, false); return fmaxf(__uint_as_float(rr[0]), __uint_as_float(rr[1])); }
__device__ __forceinline__ float max3f(float a, float b, float c) { float d; asm("v_max3_f32 %0, %1, %2, %3" : "=v"(d) : "v"(a), "v"(b), "v"(c)); return d; }
__device__ __forceinline__ float rowmax32(const f32x16& p0, const f32x16& p1) {
    float a = max3f(p0[0], p1[0], p0[1]), b = max3f(p1[1], p0[2], p1[2]);
#pragma unroll
    for (int r = 3; r < 15; r += 2) { a = max3f(a, p0[r], p1[r]); b = max3f(b, p0[r + 1], p1[r + 1]); }
    a = max3f(a, p0[15], p1[15]);
    return halfswap_max(max3f(a, b, b)); }
__device__ __forceinline__ void mask_tile(f32x16& p0, f32x16& p1, int hi, int thr_hi, int thr_lo) {
#pragma unroll
    for (int r = 0; r < 16; ++r) { const int kk = crow(r, hi); if (kk > thr_hi || kk <= thr_lo) p0[r] = NEG; if (kk + 32 > thr_hi || kk + 32 <= thr_lo) p1[r] = NEG; } }
__device__ __forceinline__ void qk_tile(const LAS char* kb, const bf16x8 (&qr)[4], f32x16& p0, f32x16& p1, int r32, int hi) {
    bf16x8 kf[8];
#pragma unroll
    for (int d0 = 0; d0 < 4; ++d0)
#pragma unroll
        for (int n = 0; n < 2; ++n) kf[2 * d0 + n] = *(const LAS bf16x8*)(kb + koff(r32 + 32 * n, 2 * d0 + hi));
    f32x16 z = {};
    p0 = MFMA32(kf[0], qr[0], z); p1 = MFMA32(kf[1], qr[0], z);
#pragma unroll
    for (int d0 = 1; d0 < 4; ++d0) { p0 = MFMA32(kf[2 * d0], qr[d0], p0); p1 = MFMA32(kf[2 * d0 + 1], qr[d0], p1); }
}
__device__ __forceinline__ void pack_p(const f32x16& p0, const f32x16& p1, bf16x8 (&pa)[4]) {
#pragma unroll
    for (int k = 0; k < 2; ++k) { u32x4 w; w.x = cvt_pk_bf16(p0[8 * k], p0[8 * k + 1]); w.y = cvt_pk_bf16(p0[8 * k + 2], p0[8 * k + 3]); w.z = cvt_pk_bf16(p0[8 * k + 4], p0[8 * k + 5]); w.w = cvt_pk_bf16(p0[8 * k + 6], p0[8 * k + 7]); pa[k] = __builtin_bit_cast(bf16x8, w);
        u32x4 v; v.x = cvt_pk_bf16(p1[8 * k], p1[8 * k + 1]); v.y = cvt_pk_bf16(p1[8 * k + 2], p1[8 * k + 3]); v.z = cvt_pk_bf16(p1[8 * k + 4], p1[8 * k + 5]); v.w = cvt_pk_bf16(p1[8 * k + 6], p1[8 * k + 7]); pa[2 + k] = __builtin_bit_cast(bf16x8, v); }
}
__device__ __forceinline__ void pv_pa(const LAS char* vb, const bf16x8 (&pa)[4], f32x16 (&o)[2], int lane, int hi) {
    const LAS char* vp = vb + ((lane >> 4) & 1) * 32 + (lane & 3) * 8 + (4 * hi + ((lane & 15) >> 2)) * 64;
#pragma unroll
    for (int k = 0; k < 4; ++k)
#pragma unroll
        for (int d0 = 0; d0 < 2; ++d0) { const s16x4 lo = vtr(vp + d0 * 4096 + k * 1024), hh = vtr(vp + d0 * 4096 + k * 1024 + 512);
            const bf16x8 vf = (bf16x8){lo[0], lo[1], lo[2], lo[3], hh[0], hh[1], hh[2], hh[3]};
            o[d0] = MFMA32(pa[k], vf, o[d0]); }
}
__device__ __forceinline__ void pv_tile(const LAS char* vb, const f32x16& p0, const f32x16& p1, f32x16 (&o)[2], int lane, int hi) { bf16x8 pa[4]; pack_p(p0, p1, pa); pv_pa(vb, pa, o, lane, hi); }
struct St { f32x16 o[2]; float mhat, l; };
__device__ __forceinline__ void softmax_step(f32x16& p0, f32x16& p1, St& st, bool first, bool rowok, LAS float* wsf, int r32, int hi) {
    float rm = rowmax32(p0, p1); rm = rowok ? rm : -3.0e38f; bool resc = false;
    if (first) st.mhat = rm;
    else { const float gr = rm - st.mhat; if (__any(gr > THR)) { const float dl = fmaxf(gr, 0.f); st.mhat += dl; const float f = __builtin_amdgcn_exp2f(-dl); st.l *= f; if (hi == 0) wsf[r32] = f; resc = true; } }
    const float nmh = rowok ? -st.mhat : -INFINITY; float sa = 0.f, sb = 0.f;
#pragma unroll
    for (int r = 0; r < 16; ++r) { p0[r] = __builtin_amdgcn_exp2f(p0[r] + nmh); p1[r] = __builtin_amdgcn_exp2f(p1[r] + nmh); sa += p0[r]; sb += p1[r]; }
    st.l += sa + sb;
    if (resc) { LDS_FENCE();
#pragma unroll
        for (int r = 0; r < 16; ++r) { const float f = wsf[crow(r, hi)]; st.o[0][r] *= f; st.o[1][r] *= f; } }
}
__device__ __forceinline__ void finish_pass(const St& st, unsigned (&omix)[16], bool firstpass, LAS float* wsf, const LAS float* gtl, int gidx, int ph, int r32, int hi, bool rowvalid) {
    const float lt = halfswap_sum(st.l); const float inv = rowvalid ? 1.0f / lt : 0.f;
    LDS_FENCE(); if (hi == 0) wsf[32 + r32] = inv; LDS_FENCE();
#pragma unroll
    for (int r = 0; r < 16; ++r) { const int q = crow(r, hi); const float s = wsf[32 + q] * gtl[(32 * ph + q) * 12 + gidx];
        float a = st.o[0][r] * s, b = st.o[1][r] * s;
        if (!firstpass) { a += __uint_as_float(omix[r] << 16); b += __uint_as_float(omix[r] & 0xffff0000u); }
        omix[r] = cvt_pk_bf16(a, b); }
}
__device__ __forceinline__ void tile_to_lds(LAS char* kb, LAS char* vb, int tid, const u32x4 kr, const u32x4 vr) {
    const int key = tid >> 3, ch = tid & 7;
    *(LAS u32x4*)(kb + koff(key, ch)) = kr; *(LAS u32x4*)(vb + (ch >> 2) * 4096 + key * 64 + (ch & 3) * 16) = vr; }
__device__ __forceinline__ void dma_tile(LAS char* kb, LAS char* vb, const bf16_t* ksrc, const bf16_t* vsrc, int tid, int wave) {
    { const int row = tid >> 3, ch = (tid & 7) ^ ((row >> 1) & 7); __builtin_amdgcn_global_load_lds((const unsigned*)(ksrc + row * 64 + ch * 8), (LAS unsigned*)(kb + wave * 1024), 16, 0, 0); }
    { const int dh = tid >> 8, row = (tid >> 2) & 63, q = tid & 3; __builtin_amdgcn_global_load_lds((const unsigned*)(vsrc + row * 64 + (dh * 4 + q) * 8), (LAS unsigned*)(vb + wave * 1024), 16, 0, 0); }
}
}

__device__ __forceinline__ void phase_attn(const Ctx& F, const bf16_t* Q, const bf16_t* KV, const bf16_t* KC, const float* GT, bf16_t* OP) {
    using namespace att;
    LAS char* L = (LAS char*)F.lds; const int wave = F.wave, head = wave & 3, ph = wave >> 2;
    LAS float* wsf = (LAS float*)(L + L_WSF) + wave * 64; LAS unsigned* selm = (LAS unsigned*)(L + L_SELM); LAS float* gtl = (LAS float*)(L + L_GT);
    LAS float* impa = (LAS float*)(L + L_IMPA); LAS float* impb = (LAS float*)(L + L_IMPB);
    LAS char* kbuf[2] = {L + L_KB0, L + L_KB1}; LAS char* vbuf[2] = {L + L_VB0, L + L_VB1};
    for (int it = F.bid; it < 1024; it += F.G) {
        const int wq = it & 255, kq = it >> 8, bg = (wq & 7) + 8 * (wq >> 5), pr = ((wq >> 3) & 3) * 4 + kq, b = bg >> 1, g = bg & 1;
#pragma unroll 1
        for (int half = 0; half < 2; ++half) {
            int tid = F.tid; asm volatile("" : "+v"(tid)); const int lane = tid & 63, r32 = lane & 31, hi = lane >> 5, posl = 32 * ph + r32;
            const int c = half ? 31 - pr : pr; const size_t t0 = (size_t)b * S_ + 64 * c; const int tt = 64 * c + posl;
            bf16x8 qr[4];
#pragma unroll
            for (int d0 = 0; d0 < 4; ++d0) qr[d0] = *(const bf16x8*)(Q + (t0 + posl) * 512 + (g * 4 + head) * 64 + d0 * 16 + hi * 8);
            for (int i = tid; i < 768; i += NTHR) gtl[i] = GT[(t0 + i / 12) * 32 + g * 12 + (i % 12)];
            dma_tile(L + L_KB2, L + L_VB2, KV + ((size_t)(2 * 2 + g) * T_ + (size_t)b * S_) * 64, KV + ((size_t)(3 * 2 + g) * T_ + (size_t)b * S_) * 64, tid, wave);
            unsigned omix[16]; int pass_slot = 2;
            { const bf16_t* kc = KC + ((size_t)(0 * 2 + g) * 4096 + b * 128) * 64; const bf16_t* vc = KC + ((size_t)(1 * 2 + g) * 4096 + b * 128) * 64;
              const u32x4 k0 = *(const u32x4*)(kc + tid * 8), v0 = *(const u32x4*)(vc + tid * 8), k1 = *(const u32x4*)(kc + 4096 + tid * 8), v1 = *(const u32x4*)(vc + 4096 + tid * 8);
              tile_to_lds(kbuf[0], vbuf[0], tid, k0, v0); tile_to_lds(kbuf[1], vbuf[1], tid, k1, v1);
              __syncthreads();
              const int nv = (tt >= 31) ? ((tt - 31) >> 4) : -1; const bool rowvalid = nv >= 0;
              const bool two = c >= 16;
              f32x16 a0, a1, b0, b1; qk_tile(kbuf[0], qr, a0, a1, r32, hi); if (two) qk_tile(kbuf[1], qr, b0, b1, r32, hi); else { b0 = f32x16{}; b1 = f32x16{}; }
              mask_tile(a0, a1, hi, rowvalid ? nv : 1000, -1); mask_tile(b0, b1, hi, (rowvalid || !two) ? nv - 64 : 1000, -1);
              St st; st.o[0] = f32x16{}; st.o[1] = f32x16{};
              st.mhat = fmaxf(rowmax32(a0, a1), rowmax32(b0, b1)); const float nmh = -st.mhat; float sacc = 0.f;
#pragma unroll
              for (int r = 0; r < 16; ++r) { a0[r] = __builtin_amdgcn_exp2f(a0[r] + nmh); a1[r] = __builtin_amdgcn_exp2f(a1[r] + nmh);
                  b0[r] = __builtin_amdgcn_exp2f(b0[r] + nmh); b1[r] = __builtin_amdgcn_exp2f(b1[r] + nmh); sacc += (a0[r] + a1[r]) + (b0[r] + b1[r]); }
              st.l = sacc;
              if (c >= 8) {
                  const float inv = rowvalid ? 1.0f / halfswap_sum(sacc) : 0.f; LAS float* ia = impa + (head * 64 + posl) * 33; LAS float* ib = impb + (head * 64 + posl) * 33;
#pragma unroll
                  for (int rr = 0; rr < 4; ++rr) {
                      { const int jb = 0 + 2 * rr + hi; ia[jb] = ((a0[4 * rr] + a0[4 * rr + 1]) + (a0[4 * rr + 2] + a0[4 * rr + 3])) * inv; ib[jb + 1] = a0[4 * rr + 3] * inv; }
                      { const int jb = 8 + 2 * rr + hi; ia[jb] = ((a1[4 * rr] + a1[4 * rr + 1]) + (a1[4 * rr + 2] + a1[4 * rr + 3])) * inv; ib[jb + 1] = a1[4 * rr + 3] * inv; }
                      { const int jb = 16 + 2 * rr + hi; ia[jb] = ((b0[4 * rr] + b0[4 * rr + 1]) + (b0[4 * rr + 2] + b0[4 * rr + 3])) * inv; ib[jb + 1] = b0[4 * rr + 3] * inv; }
                      { const int jb = 24 + 2 * rr + hi; ia[jb] = ((b1[4 * rr] + b1[4 * rr + 1]) + (b1[4 * rr + 2] + b1[4 * rr + 3])) * inv; if (jb + 1 < 32) ib[jb + 1] = b1[4 * rr + 3] * inv; }
                  }
              }
              pv_tile(vbuf[0], a0, a1, st.o, lane, hi); if (two) pv_tile(vbuf[1], b0, b1, st.o, lane, hi);
              finish_pass(st, omix, true, wsf, gtl, head * 3 + 0, ph, r32, hi, rowvalid);
            }
            __syncthreads();
            if (c >= 8) {
                LAS float* impf = (LAS float*)(L + L_KB0);
                { const int p = tid >> 3, j0 = (tid & 7) * 4; f32x4 v;
#pragma unroll
                  for (int jj = 0; jj < 4; ++jj) { const int j = j0 + jj; float val = 0.f;
#pragma unroll
                      for (int h = 0; h < 4; ++h) val += impa[(h * 64 + p) * 33 + j];
                      if (j > 0) {
#pragma unroll
                          for (int h = 0; h < 4; ++h) val += impb[(h * 64 + p) * 33 + j]; }
                      if (j > c) val = -1.0e9f; if (j == 0 || j == c) val = 1.0e9f; v[jj] = val; }
                  *(LAS f32x4*)(impf + p * 32 + j0) = v; }
                __syncthreads();
#pragma unroll 1
                for (int i2 = 0; i2 < 4; ++i2) { const int p = wave * 8 + 2 * i2 + hi, j = r32; const float my = impf[p * 32 + j]; int rank = 0;
#pragma unroll
                    for (int q = 0; q < 8; ++q) { const f32x4 v = *(const LAS f32x4*)(impf + p * 32 + q * 4);
#pragma unroll
                        for (int e = 0; e < 4; ++e) { const int i = q * 4 + e; rank += (v[e] > my || (v[e] == my && i < j)) ? 1 : 0; } }
                    const unsigned long long bal = __builtin_amdgcn_ballot_w64(rank < 8);
                    if (j == 0) selm[p] = hi ? (unsigned)(bal >> 32) : (unsigned)bal; }
            } else if (tid < 64) selm[tid] = (2u << c) - 1u;
            __syncthreads();
            const unsigned mysel = selm[posl]; unsigned uni = selm[lane];
#pragma unroll
            for (int o = 32; o >= 1; o >>= 1) uni |= __shfl_xor(uni, o);
            uni = __builtin_amdgcn_readfirstlane(uni) & ((c >= 31) ? 0xffffffffu : ((2u << c) - 1u));
#pragma unroll 1
            for (int pass = 0; pass < 2; ++pass) {
                const bf16_t* kb = KV + ((size_t)((2 + 2 * pass) * 2 + g) * T_ + (size_t)b * S_) * 64; const bf16_t* vb = KV + ((size_t)((3 + 2 * pass) * 2 + g) * T_ + (size_t)b * S_) * 64;
                unsigned um; if (pass == 0) um = uni; else { const int jl = (c >= 8) ? c - 8 : 0; um = ((c >= 31) ? 0xffffffffu : ((2u << c) - 1u)) & ~((1u << jl) - 1u); }
                int j = pass == 0 ? __builtin_ctz(um) : 31 - __builtin_clz(um); um &= ~(1u << j);
                f32x16 oo[2]; oo[0] = f32x16{}; oo[1] = f32x16{}; f32x16 ls = {}; float mhat = 0.f; int sb = pass_slot, sprev = 0; f32x16 pp0, pp1;
                u32x4 onesw = {0x3f803f80u, 0x3f803f80u, 0x3f803f80u, 0x3f803f80u}; asm volatile("" : "+v"(onesw)); const bf16x8 ones = __builtin_bit_cast(bf16x8, onesw);
                u32x4 qx = {0u, 0u, 0u, 0u}; asm volatile("" : "+v"(qx));
#define KSLOT(s) (L + ((s) == 0 ? L_KB0 : ((s) == 1 ? L_KB1 : L_KB2)))
#define VSLOT(s) (L + ((s) == 0 ? L_VB0 : ((s) == 1 ? L_VB1 : L_VB2)))
#define NEXT_TILE(jn) do { jn = -1; const int sn_ = (sb == 2) ? 0 : sb + 1; \
        if (um) { jn = pass == 0 ? __builtin_ctz(um) : 31 - __builtin_clz(um); um &= ~(1u << jn); dma_tile(KSLOT(sn_), VSLOT(sn_), kb + (size_t)jn * 4096, vb + (size_t)jn * 4096, tid, wave); } \
        else if (pass == 0) { dma_tile(KSLOT(sn_), VSLOT(sn_), KV + ((size_t)(4 * 2 + g) * T_ + (size_t)b * S_) * 64 + (size_t)c * 4096, KV + ((size_t)(5 * 2 + g) * T_ + (size_t)b * S_) * 64 + (size_t)c * 4096, tid, wave); pass_slot = sn_; } } while (0)
                bool more;
                {
                    int j1; NEXT_TILE(j1);
                    f32x16 p0, p1; qk_tile(KSLOT(sb), qr, p0, p1, r32, hi);
                    const bool rowok = (pass != 0) || (((mysel >> j) & 1u) != 0u);
                    if (j == c) mask_tile(p0, p1, hi, posl, -1); else if (pass == 1 && j == c - 8) mask_tile(p0, p1, hi, 1000, posl);
                    const float rm = rowmax32(p0, p1); mhat = __uint_as_float(cvt_pk_bf16(rm, rm) << 16); const float nmh = rowok ? -mhat : -INFINITY;
#pragma unroll
                    for (int r = 0; r < 16; ++r) { p0[r] = __builtin_amdgcn_exp2f(p0[r] + nmh); p1[r] = __builtin_amdgcn_exp2f(p1[r] + nmh); }
                    pp0 = p0; pp1 = p1; sprev = sb; more = j1 >= 0;
                    if (more) { __syncthreads(); sb = (sb == 2) ? 0 : sb + 1; j = j1; }
                }
                while (more) {
                    int j1; NEXT_TILE(j1);
                    const bool rowok = (pass != 0) || (((mysel >> j) & 1u) != 0u);
                    qx.x = hi ? 0u : (rowok ? (__float_as_uint(-mhat) >> 16) : 0xFF7Fu);
                    f32x16 p0, p1; u32x4 pw[4];
                    { const LAS char* kbp = KSLOT(sb); bf16x8 kf[8];
#pragma unroll
                      for (int d0 = 0; d0 < 2; ++d0) { kf[2 * d0] = *(const LAS bf16x8*)(kbp + koff(r32, 2 * d0 + hi)); kf[2 * d0 + 1] = *(const LAS bf16x8*)(kbp + koff(r32 + 32, 2 * d0 + hi)); }
                      f32x16 z = {}; p0 = MFMA32(ones, __builtin_bit_cast(bf16x8, qx), z); p1 = MFMA32(ones, __builtin_bit_cast(bf16x8, qx), z);
#pragma unroll
                      for (int i = 0; i < 8; ++i) { const int d0 = i >> 1;
                          if (i < 4) { const int n = i + 4; kf[n] = *(const LAS bf16x8*)(kbp + koff(r32 + 32 * (n & 1), 2 * (n >> 1) + hi)); }
                          if ((i & 1) == 0) p0 = MFMA32(kf[2 * d0], qr[d0], p0); else p1 = MFMA32(kf[2 * d0 + 1], qr[d0], p1);
#pragma unroll
                          for (int w = 2 * i; w < 2 * i + 2; ++w) { const int t = w >> 2, e = 2 * (w & 3); unsigned v;
                              if (t < 2) v = cvt_pk_bf16(pp0[8 * t + e], pp0[8 * t + e + 1]); else v = cvt_pk_bf16(pp1[8 * (t - 2) + e], pp1[8 * (t - 2) + e + 1]);
                              asm volatile("" : "+v"(v)); pw[t][w & 3] = v; }
                          __builtin_amdgcn_sched_barrier(0); }
                    }
                    if (j == c) mask_tile(p0, p1, hi, posl, -1); else if (pass == 1 && j == c - 8) mask_tile(p0, p1, hi, 1000, posl);
                    float gr = rowmax32(p0, p1); bool resc = false;
                    if (__any(gr > THR)) { const float dl = fmaxf(gr, 0.f); const float nm = __uint_as_float(cvt_pk_bf16(mhat + dl, mhat + dl) << 16); const float dq = nm - mhat; mhat = nm;
                        const float f = __builtin_amdgcn_exp2f(-dq); if (hi == 0) wsf[r32] = f; resc = true;
#pragma unroll
                        for (int r = 0; r < 16; ++r) { p0[r] -= dq; p1[r] -= dq; } }
                    asm volatile("" : "+v"(p0), "+v"(p1));
                    { const LAS char* vp = VSLOT(sprev) + ((lane >> 4) & 1) * 32 + (lane & 3) * 8 + (4 * hi + ((lane & 15) >> 2)) * 64;
#pragma unroll
                      for (int i = 0; i < 8; ++i) { const int k = i >> 1, d0 = i & 1;
                          const s16x4 lo = vtr(vp + d0 * 4096 + k * 1024), hh = vtr(vp + d0 * 4096 + k * 1024 + 512);
                          const bf16x8 vf = (bf16x8){lo[0], lo[1], lo[2], lo[3], hh[0], hh[1], hh[2], hh[3]};
                          oo[d0] = MFMA32(__builtin_bit_cast(bf16x8, pw[k]), vf, oo[d0]);
                          if (d0 == 1) ls = MFMA32(__builtin_bit_cast(bf16x8, pw[k]), ones, ls);
#pragma unroll
                          for (int r = 0; r < 4; ++r) { if (i < 4) p0[4 * i + r] = __builtin_amdgcn_exp2f(p0[4 * i + r]); else p1[4 * (i - 4) + r] = __builtin_amdgcn_exp2f(p1[4 * (i - 4) + r]); }
                          asm volatile("" : "+v"(p0), "+v"(p1));
                          __builtin_amdgcn_sched_barrier(0); }
                    }
                    if (resc) { LDS_FENCE();
#pragma unroll
                        for (int r = 0; r < 16; ++r) { const float f = wsf[crow(r, hi)]; oo[0][r] *= f; oo[1][r] *= f; ls[r] *= f; } }
                    pp0 = p0; pp1 = p1; sprev = sb; more = j1 >= 0;
                    if (more) { __syncthreads(); sb = (sb == 2) ? 0 : sb + 1; j = j1; }
                }
                { bf16x8 ppa[4]; pack_p(pp0, pp1, ppa);
                  pv_pa(VSLOT(sprev), ppa, oo, lane, hi);
#pragma unroll
                  for (int k = 0; k < 4; ++k) ls = MFMA32(ppa[k], ones, ls); }
#undef KSLOT
#undef VSLOT
#undef NEXT_TILE
#pragma unroll
                for (int r = 0; r < 16; ++r) { const int q = crow(r, hi); const float sc_ = __builtin_amdgcn_rcpf(ls[r]) * gtl[(32 * ph + q) * 12 + head * 3 + 1 + pass];
                    const float a = oo[0][r] * sc_ + __uint_as_float(omix[r] << 16), bq = oo[1][r] * sc_ + __uint_as_float(omix[r] & 0xffff0000u);
                    omix[r] = cvt_pk_bf16(a, bq); }
                __syncthreads();
            }
            { bf16_t* Ow = OP + (t0 + 32 * ph) * 1024 + (g * 4 + head) * 64; LAS bf16_t* stg = (LAS bf16_t*)(L + L_STG) + wave * 2048;
#pragma unroll
              for (int r = 0; r < 16; ++r) { const int orow = crow(r, hi);
#pragma unroll
                  for (int d0 = 0; d0 < 2; ++d0) stg[orow * 64 + d0 * 32 + r32] = (bf16_t)(d0 ? (omix[r] >> 16) : (omix[r] & 0xffffu)); }
              LDS_FENCE();
#pragma unroll
              for (int i = 0; i < 4; ++i) { const int row = i * 8 + (lane >> 3), ch = lane & 7; *(u32x4*)(Ow + (size_t)row * 1024 + ch * 8) = *(const LAS u32x4*)(stg + row * 64 + ch * 8); } }
            __syncthreads();
        }
    }
}

__device__ __forceinline__ int moe_tile_starts(const int* cnt, int (&ts)[NE_ + 1]) {
    int acc = 0;
#pragma unroll
    for (int e = 0; e < NE_; ++e) { ts[e] = acc; acc += (cnt[e] + 255) >> 8; }
    ts[NE_] = acc; return acc;
}
__device__ __forceinline__ void phase_moe_assign(const Ctx& F, const int* wgcnt, int* cnt, const int* tok_e, const int* tok_p, int* row_tok, int* row_dst) {
    LAS int* pre = (LAS int*)F.lds;
    for (int i = F.tid; i < F.G * 8; i += NTHR) pre[i] = wgcnt[i];
    __syncthreads();
    if (F.tid < 8) { int acc = 0; for (int w = 0; w < F.G; ++w) { const int v = pre[w * 8 + F.tid]; pre[w * 8 + F.tid] = acc; acc += v; } pre[F.G * 8 + F.tid] = acc; if (F.bid == 0) cnt[F.tid] = acc; }
    __syncthreads();
    int ts[NE_ + 1]; { int acc = 0;
#pragma unroll
        for (int e = 0; e < NE_; ++e) { ts[e] = acc; acc += (pre[F.G * 8 + e] + 255) >> 8; } ts[NE_] = acc; }
    for (int idx = F.bid * NTHR + F.tid; idx < T_ * 2; idx += F.G * NTHR) { const int e = tok_e[idx]; int st = 0;
#pragma unroll
        for (int k = 0; k < NE_; ++k) st = (k == e) ? ts[k] : st;
        const int r = idx >> 1, w = (T_ % (F.G * NWAVES) == 0) ? r / (T_ / F.G) : (r % (F.G * NWAVES)) / NWAVES;
        const int row = st * 256 + pre[w * 8 + e] + tok_p[idx]; row_tok[row] = r; row_dst[row] = idx; }
}
__device__ __forceinline__ void phase_moe_gather(const Ctx& F, const bf16_t* f, const int* row_tok, bf16_t* xs, int nrows) {
    for (int r = F.bid * NWAVES + F.wave; r < nrows; r += F.G * NWAVES) { const bf16_t* src = f + (size_t)row_tok[r] * 1024; bf16_t* dst = xs + (size_t)r * 1024;
        *(u32x4*)(dst + F.lane * 8) = *(const u32x4*)(src + F.lane * 8); *(u32x4*)(dst + 512 + F.lane * 8) = *(const u32x4*)(src + 512 + F.lane * 8); }
}
__device__ __forceinline__ void phase_moe_combine(const Ctx& F, bf16_t* h, float* outf, const bf16_t* yb, const float* tok_g, const float* g, bf16_t* dst) {
    f32x4 gv[4];
#pragma unroll
    for (int i = 0; i < 2; ++i) { gv[2 * i] = *(const f32x4*)(g + i * 512 + F.lane * 8); gv[2 * i + 1] = *(const f32x4*)(g + i * 512 + F.lane * 8 + 4); }
    u32x4 nh[2], ny0[2], ny1[2]; float ng0 = 0.f, ng1 = 0.f;
#define CMB_LOAD(row_) do { const int r_ = (row_); ng0 = tok_g[r_ * 2]; ng1 = tok_g[r_ * 2 + 1]; _Pragma("unroll") for (int i = 0; i < 2; ++i) { const int c = i * 512 + F.lane * 8; \
        nh[i] = *(const u32x4*)(h + (size_t)r_ * 1024 + c); ny0[i] = *(const u32x4*)(yb + (size_t)(r_ * 2) * 1024 + c); ny1[i] = *(const u32x4*)(yb + (size_t)(r_ * 2 + 1) * 1024 + c); } } while (0)
    { const int row = F.bid * NWAVES + F.wave; if (row < T_) CMB_LOAD(row); }
    for (int row = F.bid * NWAVES + F.wave; row < T_; row += F.G * NWAVES) { const float g0 = ng0, g1 = ng1; bf16_t* hr = h + (size_t)row * 1024; f32x4 v[4]; float ss = 0.f;
#pragma unroll
        for (int i = 0; i < 2; ++i) { f32x4 ha, hb, a0, b0, a1, b1; pg8::unpack8(nh[i], ha, hb); pg8::unpack8(ny0[i], a0, b0); pg8::unpack8(ny1[i], a1, b1);
            v[2 * i] = ha + a0 * g0 + a1 * g1; v[2 * i + 1] = hb + b0 * g0 + b1 * g1; }
#pragma unroll
        for (int i = 0; i < 4; ++i) ss += v[i][0] * v[i][0] + v[i][1] * v[i][1] + v[i][2] * v[i][2] + v[i][3] * v[i][3];
        { const int nrow = row + F.G * NWAVES; if (nrow < T_) CMB_LOAD(nrow); }
        ss = wave_sum(ss); const float r = rsqrtf(ss * (1.0f / 1024.0f) + 1e-6f);
        if (dst) {
#pragma unroll
            for (int i = 0; i < 2; ++i) { const int c = i * 512 + F.lane * 8; *(u32x4*)(hr + c) = pg8::pack8(v[2 * i], v[2 * i + 1]);
                *(u32x4*)(dst + (size_t)row * 1024 + c) = pg8::pack8(v[2 * i] * r * gv[2 * i], v[2 * i + 1] * r * gv[2 * i + 1]); }
        } else {
#pragma unroll
            for (int i = 0; i < 2; ++i) { const int c = i * 512 + F.lane * 8; *(f32x4*)(outf + (size_t)row * 1024 + c) = v[2 * i] * r * gv[2 * i]; *(f32x4*)(outf + (size_t)row * 1024 + c + 4) = v[2 * i + 1] * r * gv[2 * i + 1]; }
        }
    }
#undef CMB_LOAD
}

#define bufA ((bf16_t*)(ws + WS_BUFA))
#define Qb ((bf16_t*)(ws + R1_Q))
#define KVb ((bf16_t*)(ws + R1_KV))
#define Ub ((bf16_t*)(ws + R1_U))
#define GTb ((float*)(ws + R1_GT))
#define RATIOb ((bf16_t*)(ws + R1_RATIO))
#define S1b ((bf16_t*)(ws + R1_S1))
#define MERGEDb ((bf16_t*)(ws + R1_MERGED))
#define HCb ((bf16_t*)(ws + WS_HC))
#define KCb ((bf16_t*)(ws + WS_KC))
#define tok_e ((int*)(ws + WS_TOKE))
#define tok_p ((int*)(ws + WS_TOKP))
#define tok_g ((float*)(ws + WS_TOKG))
#define row_tok ((int*)(ws + WS_ROWT))
#define row_dst ((int*)(ws + WS_ROWD))
template <unsigned TMASK>
__global__ void __launch_bounds__(NTHR, 2) fwd(Params p0) {
    extern __shared__ __attribute__((aligned(16))) unsigned char lds_raw[];
    Ctx F; F.lds = (LAS unsigned char*)lds_raw; F.tid = threadIdx.x; F.lane = F.tid & 63; F.wave = __builtin_amdgcn_readfirstlane(F.tid >> 6); F.G = gridDim.x; F.bid = blockIdx.x;
    volatile LAS unsigned* MISC = (volatile LAS unsigned*)(F.lds + MISC_OFF);
    if (F.tid < 64) MISC[F.tid] = 0u;
    __syncthreads();
    XcdBarrier bar; bar.bar = (unsigned*)(p0.ws + WS_CTL); bar.x = 0; bar.st = nullptr;
    if (!MK_PER_PHASE) bar = xcd_barrier_post((unsigned*)(p0.ws + WS_CTL), MISC + 8);
    const int lo = p0.ph_lo, hi = p0.ph_hi; int ph = 0;
#define PH_BEGIN(k) if constexpr ((TMASK >> (k)) & 1u) if (ph >= lo && ph < hi) { Params p; load_params(p); unsigned char* ws = launder_ws(p.ws); asm volatile("v_mbcnt_lo_u32_b32 %0, -1, 0\n\tv_mbcnt_hi_u32_b32 %0, -1, %0" : "=v"(F.lane)); F.wave = __builtin_amdgcn_readfirstlane(F.wave); asm volatile("" : "+s"(F.wave)); F.tid = F.wave * 64 + F.lane;
#define PH_END   if (ph + 1 < hi) { if (!MK_PER_PHASE) xcd_barrier(relaunder_bar(bar)); } } ++ph;

    for (int L = 0; L < DEPTH_; ++L) {
        const int j = L >> 1; const bool moe = (L & 1) != 0;
#define HB ((bf16_t*)(ws + WS_H))
#define cnt ((int*)(ws + WS_CTL + CTL_CNT) + j * 16)
#define wgcnt ((int*)(ws + WS_CTL + 20480) + j * 2048)
        if (L == 0 || ((L - 1) & 1) == 0) {
        PH_BEGIN(0)
            if (L == 0) phase_prep_mixer(F, p, 0);
            if (L == 0) phase_norm<false, false>(F, p.x, p.norm_mix_g, bufA, nullptr, nullptr, nullptr, nullptr, nullptr, nullptr, nullptr, nullptr);
            else phase_norm_b8(F, HB, p.norm_mix_g + (size_t)L * 1024, bufA);
        PH_END
        }
        PH_BEGIN(1)
            pg8::Gemm g{bufA, (const bf16_t*)(ws + W_IN_(L)), 1024, 1024}; pg8::Order S; S.init(T_ / 256, 16, F.G, F.bid); S.wgm = 4;
            pg8::EpiProj E{Qb, KVb, Ub, GTb, RATIOb, S1b};
            pg8::gemm_phase<pg8::EpiProj>(F.lds, F.wave, g, S, E);
        PH_END
        PH_BEGIN(2)
            if (F.bid < 64) { pg8::Gemm g{KVb, (const bf16_t*)(ws + W_C1_(L)), 1024, 2048}; pg8::Order S; S.init(64, 1, 64, F.bid); S.mode = 1; S.pbdiv = 32;
                pg8::EpiCmpH E{HCb, (const float*)(ws + W_B1_(L))};
                pg8::gemm_phase<pg8::EpiCmpH>(F.lds, F.wave, g, S, E);
                pg8::Unit u0; S.next(0, u0); asm volatile("s_waitcnt vmcnt(0)" ::: "memory"); __syncthreads();
                phase_cmp2(F, HCb, p.cmp_w2 + (size_t)L * 2 * 256 * 64, KCb, u0.pm * 4, u0.pm * 4 + 4, 1); }
            else { Ctx F2 = F; F2.bid = F.bid - 64; F2.G = F.G - 64;
                phase_pool(F2, Ub, bufA); phase_prep_ffn(F2, p, L); if (L + 1 < DEPTH_) phase_prep_mixer(F2, p, L + 1); }
        PH_END
        PH_BEGIN(4)
            phase_attn(F, Qb, KVb, KCb, GTb, bufA);
        PH_END
        PH_BEGIN(5)
            pg8::Gemm g{bufA, (const bf16_t*)(ws + W_M_(L)), 1024, 1024}; pg8::Order S; S.init(T_ / 256, 4, F.G, F.bid);
            pg8::EpiMerge E{RATIOb, S1b, MERGEDb};
            pg8::gemm_phase<pg8::EpiMerge>(F.lds, F.wave, g, S, E);
        PH_END
        PH_BEGIN(6)
            pg8::Gemm g{MERGEDb, (const bf16_t*)(ws + W_O_(L)), 1024, 1024}; pg8::Order S; S.init(T_ / 256, 4, F.G, F.bid);
            pg8::EpiResid E{(L == 0) ? (const void*)p.x : (const void*)HB, HB, L == 0};
            pg8::gemm_phase<pg8::EpiResid>(F.lds, F.wave, g, S, E);
        PH_END
        if (!moe) {
            PH_BEGIN(7)
                phase_norm_b8(F, HB, p.norm_ffn_g + (size_t)L * 1024, bufA);
            PH_END
            PH_BEGIN(8)
                pg8::Gemm g{bufA, (const bf16_t*)(ws + W_FF), 1024, 1024}; pg8::Order S; S.init(T_ / 256, 2 * DFF_ / 256, F.G, F.bid);
                pg8::EpiSwiglu E{(bf16_t*)(ws + R1_HF), DFF_};
                pg8::gemm_phase<pg8::EpiSwiglu>(F.lds, F.wave, g, S, E);
            PH_END
            PH_BEGIN(9)
                pg8::Gemm g{(const bf16_t*)(ws + R1_HF), (const bf16_t*)(ws + W_FFD_DENSE), DFF_, DFF_}; pg8::Order S; S.init(T_ / 256, 4, F.G, F.bid);
                pg8::EpiResid E{(const void*)HB, HB, false};
                pg8::gemm_phase<pg8::EpiResid>(F.lds, F.wave, g, S, E);
            PH_END
        } else {
            PH_BEGIN(10)
                phase_norm<true, true>(F, HB, p.norm_ffn_g + (size_t)L * 1024, bufA, p.moe_w_router + (size_t)j * 1024 * 8, p.moe_b_router + j * 8, wgcnt, tok_e, tok_p, tok_g, row_tok, row_dst);
            PH_END
            PH_BEGIN(11)
                phase_moe_assign(F, wgcnt, cnt, tok_e, tok_p, row_tok, row_dst);
            PH_END
            for (int s = 0; s < MOE_MAX_CHUNKS; ++s) {
                int ts[NE_ + 1]; const int NT = moe_tile_starts((const int*)(p0.ws + WS_CTL + CTL_CNT) + j * 16, ts);
                PH_BEGIN(13)
#define MOE_NTC(c_) ((NT - (c_) * MOE_CH_TILES) < 0 ? 0 : ((NT - (c_) * MOE_CH_TILES) > MOE_CH_TILES ? MOE_CH_TILES : (NT - (c_) * MOE_CH_TILES)))
#define MOE_HM(c_) (ws + ((c_) == MOE_NFULL ? WS_HM2 : (((c_) & 1) ? WS_HM1 : R1_HM)))
#define MOE_DOWN(c_) do { const int c = (c_); int ntc = MOE_NTC(c); if (c == MOE_NFULL && ntc > 8) ntc = 8; const int row0 = c * MOE_CH_TILES * 256; \
                        if (ntc > 0) { pg8::Gemm g{(const bf16_t*)MOE_HM(c), (const bf16_t*)(ws + W_FFD_MOE), DFE_, DFE_}; pg8::Order S; S.init(ntc, 4, F.G, F.bid); S.mode = 2; S.tile0 = c * MOE_CH_TILES; \
                            _Pragma("unroll") for (int k = 0; k <= NE_; ++k) S.ts[k] = ts[k]; \
                            pg8::EpiScatter E{(bf16_t*)(ws + R1_YB), row_dst + row0}; \
                            pg8::gemm_phase<pg8::EpiScatter>(F.lds, F.wave, g, S, E); } } while (0)
#define MOE_UP(c_, nskip_) do { const int c = (c_); int ntc = MOE_NTC(c); if (c == MOE_NFULL && ntc > 8) ntc = 8; const int row0 = c * MOE_CH_TILES * 256; \
                        if (ntc > 0) { pg8::Gemm g{bufA, (const bf16_t*)(ws + W_FF), 1024, 1024}; pg8::Order S; S.init(ntc, 2 * DFE_ / 256, F.G, F.bid); S.mode = 2; S.tile0 = c * MOE_CH_TILES; S.set_skip(nskip_); \
                            _Pragma("unroll") for (int k = 0; k <= NE_; ++k) S.ts[k] = ts[k]; \
                            pg8::EpiSwiglu E{(bf16_t*)MOE_HM(c), DFE_}; \
                            pg8::gemm_phase<pg8::EpiSwiglu, true>(F.lds, F.wave, g, S, E, row_tok + row0); } } while (0)
                    if (s == 0) { MOE_UP(MOE_NFULL, 0); MOE_UP(0, 0); }
                    else { int ntail = MOE_NTC(MOE_NFULL); ntail = ntail > 8 ? 8 : ntail;
                        if (s == 1) MOE_DOWN(MOE_NFULL);
                        MOE_DOWN(s - 1);
                        if (s < MOE_NFULL) MOE_UP(s, s == 1 ? 4 * ntail : 0); }
#undef MOE_NTC
#undef MOE_HM
#undef MOE_DOWN
#undef MOE_UP
                PH_END
            }
            PH_BEGIN(15)
                if (L + 1 < DEPTH_) phase_moe_combine(F, HB, nullptr, (const bf16_t*)(ws + R1_YB), tok_g, p.norm_mix_g + (size_t)(L + 1) * 1024, bufA);
                else phase_moe_combine(F, HB, p.out, (const bf16_t*)(ws + R1_YB), tok_g, p.final_norm_g, nullptr);
            PH_END
        }
    }
#undef PH_BEGIN
#undef PH_END
}

constexpr int N_PHASES = DEPTH_ * 6 - 1 + 2 * 3 + 2 * (2 + MOE_MAX_CHUNKS + 1);
constexpr int N_TYPES = 17;
constexpr unsigned ALL_TYPES = (1u << N_TYPES) - 1u;

typedef void (*kern_t)(Params);
template <int K> struct KernTab { static void fill(kern_t* t) { t[K] = fwd<(1u << K)>; KernTab<K - 1>::fill(t); } };
template <> struct KernTab<-1> { static void fill(kern_t*) {} };

extern "C" void kernel_launch(void* const* d_in, const int* in_sizes, int n_in, void* d_out, int out_size, void* d_ws, size_t ws_size, hipStream_t stream) {
    static int grid = 0;
    static kern_t ktab[N_TYPES + 1];
    static int ptype[N_PHASES];
    if (grid == 0) {
        if (n_in != 21 || out_size != T_ * D_ || ws_size < WS_END) { fprintf(stderr, "kernel_launch: unexpected problem (n_in %d out %d ws %zu need %zu)\n", n_in, out_size, ws_size, (size_t)WS_END); grid = -1; return; }
        int dev = 0, cus = 0;
        if (hipGetDevice(&dev) != hipSuccess || hipDeviceGetAttribute(&cus, hipDeviceAttributeMultiprocessorCount, dev) != hipSuccess) { grid = -1; return; }
#if MK_PER_PHASE
        KernTab<N_TYPES - 1>::fill(ktab);
        for (int k = 0; k < N_TYPES; ++k) if (hipFuncSetAttribute((const void*)ktab[k], hipFuncAttributeMaxDynamicSharedMemorySize, LDS_BYTES) != hipSuccess) { grid = -1; return; }
        { int n = 0; for (int L = 0; L < DEPTH_; ++L) { for (int k = 0; k < 7; ++k) if (k != 3 && (k > 0 || L != 2)) ptype[n++] = k;
              if ((L & 1) == 0) { ptype[n++] = 7; ptype[n++] = 8; ptype[n++] = 9; }
              else { ptype[n++] = 10; ptype[n++] = 11; for (int c = 0; c < MOE_MAX_CHUNKS; ++c) ptype[n++] = 13; ptype[n++] = 15; } }
          if (n != N_PHASES) { fprintf(stderr, "phase table mismatch %d\n", n); grid = -1; return; } }
#else
        ktab[N_TYPES] = fwd<ALL_TYPES>;
        if (hipFuncSetAttribute((const void*)ktab[N_TYPES], hipFuncAttributeMaxDynamicSharedMemorySize, LDS_BYTES) != hipSuccess) { grid = -1; return; }
        int per_cu = 0;
        if (hipOccupancyMaxActiveBlocksPerMultiprocessor(&per_cu, (const void*)ktab[N_TYPES], NTHR, LDS_BYTES) != hipSuccess || per_cu < 1) { fprintf(stderr, "kernel_launch: occupancy query reports %d\n", per_cu); }
        (void)hipGetLastError();
#endif
        grid = cus;
    }
    if (grid < 0) return;
    (void)hipMemsetAsync((char*)d_ws + WS_CTL, 0, CTL_BYTES, stream);
    Params p{};
    const float** pp = (const float**)&p;
    for (int i = 0; i < 21; ++i) pp[i] = (const float*)d_in[i];
    p.out = (float*)d_out; p.ws = (unsigned char*)d_ws;
#if MK_PER_PHASE
    for (int ph = 0; ph < N_PHASES; ++ph) { p.ph_lo = ph; p.ph_hi = ph + 1; hipLaunchKernelGGL(ktab[ptype[ph]], dim3(grid), dim3(NTHR), LDS_BYTES, stream, p); }
#else
    p.ph_lo = 0; p.ph_hi = N_PHASES; hipLaunchKernelGGL(ktab[N_TYPES], dim3(grid), dim3(NTHR), LDS_BYTES, stream, p);
#endif
}
```

```cpp
#include <hip/hip_runtime.h>
#include <cstdio>
#include <cstdint>

#ifndef GEMM_ALIGN_EPI
#define GEMM_ALIGN_EPI true
#endif
#ifndef MK_PER_PHASE
#define MK_PER_PHASE 0
#endif

#define LAS __attribute__((address_space(3)))
typedef unsigned short bf16_t;
typedef short bf16x8 __attribute__((ext_vector_type(8)));
typedef float f32x4 __attribute__((ext_vector_type(4)));
typedef float f32x2 __attribute__((ext_vector_type(2)));
typedef unsigned u32x4 __attribute__((ext_vector_type(4)));
typedef unsigned u32x2 __attribute__((ext_vector_type(2)));

constexpr int T_ = 65536, S_ = 2048, NB_ = 32, D_ = 1024, DEPTH_ = 4;
constexpr int INC_ = 3864;
constexpr int DFF_ = 2816, DFE_ = 3584, NE_ = 8;
constexpr int MOE_CH_TILES = 64;
constexpr int MOE_NFULL = 512 / MOE_CH_TILES;
constexpr int MOE_MAX_TILES = 520;
constexpr int MOE_MAX_CHUNKS = MOE_NFULL + 1;
constexpr int MOE_ROWS = MOE_MAX_TILES * 256;
constexpr int YB_DUMMY = 131072;

constexpr size_t WS_CTL = 0, CTL_BYTES = 65536;
constexpr size_t CTL_CNT = 16384;
constexpr size_t WS_BUFA = WS_CTL + CTL_BYTES;
constexpr size_t SZ_BUFA = (size_t)T_ * 1024 * 2;
constexpr size_t WS_R1 = WS_BUFA + SZ_BUFA;
constexpr size_t R1_Q = WS_R1;
constexpr size_t R1_KV = R1_Q + (size_t)T_ * 512 * 2;
constexpr size_t R1_U = R1_KV + (size_t)12 * T_ * 64 * 2 + 65536;
constexpr size_t R1_GT = R1_U + (size_t)T_ * 512 * 2;
constexpr size_t R1_RATIO = R1_GT + (size_t)T_ * 32 * 4;
constexpr size_t R1_S1 = R1_RATIO + (size_t)T_ * 1024 * 2;
constexpr size_t R1_END = R1_S1 + (size_t)T_ * 1024 * 2;
constexpr size_t R1_MERGED = R1_Q;
constexpr size_t R1_HF = WS_R1;
constexpr size_t R1_HM = WS_R1;
constexpr size_t R1_YB = R1_HM + (size_t)MOE_CH_TILES * 256 * DFE_ * 2;
constexpr size_t R1_YB_END = R1_YB + (size_t)(131072 + 256) * 1024 * 2;
static_assert(R1_YB_END <= R1_END, "moe overlay");
static_assert((size_t)T_ * DFF_ * 2 <= R1_END - WS_R1, "dense overlay");
constexpr size_t WS_HC = R1_END;
constexpr size_t WS_KC = WS_HC + (size_t)16384 * 256 * 2;
constexpr size_t WS_TOKE = WS_KC + (size_t)16384 * 64 * 2;
constexpr size_t WS_TOKP = WS_TOKE + (size_t)T_ * 2 * 4;
constexpr size_t WS_TOKG = WS_TOKP + (size_t)T_ * 2 * 4;
constexpr size_t WS_ROWT = WS_TOKG + (size_t)T_ * 2 * 4;
constexpr size_t WS_ROWD = WS_ROWT + (size_t)MOE_ROWS * 4 + 1024;
constexpr size_t WS_W = WS_ROWD + (size_t)MOE_ROWS * 4 + 1024;
constexpr size_t MIX_IN = 0;
constexpr size_t MIX_C1 = MIX_IN + (size_t)4096 * 1024 * 2;
constexpr size_t MIX_B1 = MIX_C1 + (size_t)2 * 256 * 2048 * 2;
constexpr size_t MIX_M = MIX_B1 + 4096;
constexpr size_t MIX_O = MIX_M + (size_t)1024 * 1024 * 2;
constexpr size_t MIX_BYTES = MIX_O + (size_t)1024 * 1024 * 2;
#define W_IN_(L) (WS_W + (size_t)((L) & 1) * MIX_BYTES + MIX_IN)
#define W_C1_(L) (WS_W + (size_t)((L) & 1) * MIX_BYTES + MIX_C1)
#define W_B1_(L) (WS_W + (size_t)((L) & 1) * MIX_BYTES + MIX_B1)
#define W_M_(L)  (WS_W + (size_t)((L) & 1) * MIX_BYTES + MIX_M)
#define W_O_(L)  (WS_W + (size_t)((L) & 1) * MIX_BYTES + MIX_O)
constexpr size_t W_FF = WS_W + 2 * MIX_BYTES;
constexpr size_t W_FFD_DENSE = W_FF + (size_t)2 * DFF_ * 1024 * 2;
constexpr size_t W_FFD_MOE = W_FF + (size_t)NE_ * 2 * DFE_ * 1024 * 2;
constexpr size_t WS_HM1 = W_FFD_MOE + (size_t)NE_ * 1024 * DFE_ * 2;
constexpr size_t WS_HM2 = WS_HM1 + (size_t)MOE_CH_TILES * 256 * DFE_ * 2;
constexpr size_t WS_H = WS_HM2 + (size_t)8 * 256 * DFE_ * 2;
constexpr size_t WS_END = WS_H + (size_t)T_ * 1024 * 2;
static_assert(WS_END <= (size_t)1157000000, "workspace budget (sum of the inputs = 1,157,673,024 bytes)");

__device__ __forceinline__ float bf2f(bf16_t v) { return __uint_as_float(((unsigned)v) << 16); }
__device__ __forceinline__ bf16_t f2bf(float f) { unsigned u = __float_as_uint(f); u += 0x7FFFu + ((u >> 16) & 1u); return (bf16_t)(u >> 16); }
__device__ __forceinline__ unsigned cvt_pk_bf16(float lo, float hi) { unsigned r; asm("v_cvt_pk_bf16_f32 %0, %1, %2" : "=v"(r) : "v"(lo), "v"(hi)); return r; }
__device__ __forceinline__ float wave_sum(float v) {
#pragma unroll
    for (int o = 32; o >= 1; o >>= 1) v += __shfl_xor(v, o);
    return v; }
__device__ __forceinline__ float wave_max(float v) {
#pragma unroll
    for (int o = 32; o >= 1; o >>= 1) v = fmaxf(v, __shfl_xor(v, o));
    return v; }
__device__ __forceinline__ float frcp(float x) { return __builtin_amdgcn_rcpf(x); }
__device__ __forceinline__ float fexpn(float x) { return __builtin_amdgcn_exp2f(x * -1.4426950408889634f); }
__device__ __forceinline__ float sigmoidf_(float x) { x = fminf(fmaxf(x, -30.f), 30.f); return frcp(1.0f + fexpn(x)); }
#define LDS_FENCE() asm volatile("s_waitcnt lgkmcnt(0)" ::: "memory")

#define XB_TMO      128
#define XB_XCNT(j)  (256  + 64 * (j))
#define XB_XSUB(j)  (1280 + 64 * (j))
#define XB_XGEN(j)  (2304 + 64 * (j))
#define XB_TOP      3328
#define XB_TOPGEN   3392
#define XCD_BAR_WORDS 3456
#define XB_SPIN_CAP (1u << 21)
__device__ __forceinline__ unsigned xb_ld(unsigned* p)              { return __hip_atomic_load(p, __ATOMIC_RELAXED, __HIP_MEMORY_SCOPE_AGENT); }
__device__ __forceinline__ unsigned xb_add(unsigned* p, unsigned v) { return __hip_atomic_fetch_add(p, v, __ATOMIC_RELAXED, __HIP_MEMORY_SCOPE_AGENT); }
__device__ __forceinline__ unsigned xb_xcc_id() { return (unsigned)__builtin_amdgcn_s_getreg((3 << 11) | 20) & 0xFu; }
#define XB_SPIN(cond, bar) do { unsigned _sp = 0; while (cond) { __builtin_amdgcn_s_sleep(1); \
    if ((++_sp & 255u) == 0u) { if (xb_ld(&(bar)[XB_TMO])) break; if (_sp > XB_SPIN_CAP) { atomicAdd(&(bar)[XB_TMO], 1u); break; } } } } while (0)
struct XcdBarrier { unsigned* bar; unsigned x; volatile LAS unsigned* st; };
__device__ __forceinline__ XcdBarrier xcd_barrier_post(unsigned* bar, volatile LAS unsigned* st) {
    XcdBarrier b; b.bar = bar; b.x = xb_xcc_id(); b.st = st;
    if (threadIdx.x == 0) (void)xb_add(&bar[XB_XCNT(b.x)], 1u);
    return b;
}
__device__ __forceinline__ void xcd_barrier_complete(unsigned* bar, unsigned x, unsigned& nloc, unsigned& nx) {
    asm volatile("" : "+s"(x));
    const unsigned G = gridDim.x * gridDim.y * gridDim.z;
    unsigned sum, cnt, mine, sp = 0u;
    for (;;) {
        sum = 0u; cnt = 0u; mine = 0u;
#pragma unroll
        for (unsigned j = 0; j < 16; ++j) { const unsigned c = xb_ld(&bar[XB_XCNT(j)]); sum += c; cnt += (c > 0u) ? 1u : 0u; mine = (j == x) ? c : mine; }
        if (sum == G) break;
        __builtin_amdgcn_s_sleep(1);
        if ((++sp & 255u) == 0u) { if (xb_ld(&bar[XB_TMO])) break; if (sp > XB_SPIN_CAP) { atomicAdd(&bar[XB_TMO], 1u); break; } }
    }
    nloc = mine > 0u ? mine : 1u; nx = cnt > 0u ? cnt : 1u;
}
__device__ __forceinline__ void xcd_barrier(const XcdBarrier& b) {
    asm volatile("s_waitcnt vmcnt(0)" ::: "memory");
    __syncthreads();
    if (threadIdx.x == 0) {
        unsigned* bar = b.bar;
        __builtin_amdgcn_s_waitcnt(0);
        unsigned nloc = b.st[0], nx = b.st[1];
        if (nloc == 0u) { xcd_barrier_complete(bar, b.x, nloc, nx); b.st[0] = nloc; b.st[1] = nx; }
        const unsigned old = xb_add(&bar[XB_XSUB(b.x)], 1u);
        const unsigned gen = old / nloc;
        if (old + 1u == (gen + 1u) * nloc) {
            __builtin_amdgcn_fence(__ATOMIC_RELEASE, "agent");
            asm volatile("s_waitcnt vmcnt(0)" ::: "memory");
            const unsigned og = xb_add(&bar[XB_TOP], 1u);
            const unsigned tg = og / nx;
            if (og + 1u == (tg + 1u) * nx) xb_add(&bar[XB_TOPGEN], 1u);
            else XB_SPIN(xb_ld(&bar[XB_TOPGEN]) == tg, bar);
            __builtin_amdgcn_fence(__ATOMIC_ACQUIRE, "agent");
            xb_add(&bar[XB_XGEN(b.x)], 1u);
            asm volatile("s_waitcnt vmcnt(0)" ::: "memory");
        } else {
            XB_SPIN(xb_ld(&bar[XB_XGEN(b.x)]) == gen, bar);
            __builtin_amdgcn_fence(__ATOMIC_ACQUIRE, "agent");
            asm volatile("s_waitcnt vmcnt(0)" ::: "memory");
        }
    }
    __syncthreads();
}

namespace pg8 {
constexpr int BM = 256, BK = 64, HALF = 128, HTB = HALF * BK * 2, STAGE_BYTES = 8 * HTB, NXCD = 8, WGM = 8;
__host__ __device__ __forceinline__ int lds_byte(int r, int c) { const int st = (r >> 4) * 2 + (c >> 5), rr = r & 15, cc = c & 31, ob = rr * 64 + cc * 2; return st * 1024 + (ob ^ (((ob >> 9) & 1) << 5)); }
__host__ __device__ __forceinline__ void stage_rc(int b, int& R, int& C) { const int st = b / 1024, sb = b % 1024, swz = sb ^ (((sb >> 9) & 1) << 5); R = (st >> 1) * 16 + swz / 64; C = (st & 1) * 32 + (swz % 64) / 2; }
__host__ __device__ __forceinline__ int perm32(int rho) { const int n = rho >> 4, i = rho & 15; return 8 * (i >> 2) + 4 * n + (i & 3); }

struct Unit { int pm, pn, pb; };
struct Gemm { const bf16_t* A; const bf16_t* Bt; int lda, K; };

struct Order {
    int nM, nN, nwg, G, c, mode, pbdiv, tile0, nsk; int ts[NE_ + 1];
    __device__ __forceinline__ void init(int nM_, int nN_, int G_, int c_) { nM = nM_; nN = nN_; nwg = nM * nN; G = G_; c = c_; mode = 0; pbdiv = 1; tile0 = 0; nsk = 0; }
    __device__ __forceinline__ void set_skip(int n) { nsk = (n > 0 && n * 5 <= G && nwg >= 6 * G) ? n : 0; }
    __device__ __forceinline__ bool next(int i, Unit& u) const {
        long L = (long)i * G + c;
        if (nsk > 0) { if (c < nsk) L += 4L * G;
            else if (L >= nwg) { const int e = c - (G - 4 * nsk); if (e < 0 || L - G >= nwg) return false; L = (long)(e & 3) * G + (e >> 2); } }
        if (L >= nwg) return false;
        int wgid = (int)L; { const int q = nwg / NXCD, r = nwg % NXCD, xcd = wgid % NXCD, off = wgid / NXCD; wgid = (xcd < r ? xcd * (q + 1) : r * (q + 1) + (xcd - r) * q) + off; }
        const int nig = WGM * nN, gid = wgid / nig, fm = gid * WGM, gsz = (nM - fm) < WGM ? (nM - fm) : WGM;
        u.pm = fm + ((wgid % nig) % gsz); u.pn = (wgid % nig) / gsz;
        if (mode == 0) u.pb = u.pn;
        else if (mode == 1) u.pb = (u.pm / pbdiv) * nN + u.pn;
        else { const int tile = tile0 + u.pm; int e = 0;
#pragma unroll
            for (int k = 1; k < NE_; ++k) e += (tile >= ts[k]) ? 1 : 0;
            u.pb = e * nN + u.pn; }
        return true;
    }
};

template <class Epi, bool GATHER = false>
__device__ __forceinline__ void gemm_phase(LAS unsigned char* lds, int wave_id, const Gemm g, const Order& S, const Epi& E, const int* rowtok = nullptr) {
    int lane; asm volatile("v_mbcnt_lo_u32_b32 %0, -1, 0\n\tv_mbcnt_hi_u32_b32 %0, -1, %0" : "=v"(lane));
    const int wid = wave_id, tid = wid * 64 + lane, wr = wid >> 2, wc = wid & 3, fr = lane & 15, fq = lane >> 4;
    const int K = g.K, lda = g.lda, nt = K / BK; constexpr bool ALIGN_EPI = GEMM_ALIGN_EPI;
    unsigned vA[2][2], voffB[2]; LAS int* gtab = (LAS int*)(lds + STAGE_BYTES + 2048);
    const size_t kstep = (size_t)(BK * 2);
    const size_t hstepA = (size_t)HALF * lda * 2, hstepB = (size_t)HALF * K * 2;
    const size_t tstepA = GATHER ? 0 : 2 * hstepA, tstepB = 2 * hstepB;
#pragma unroll
    for (int i = 0; i < 2; ++i) { int R, C; stage_rc(tid * 16 + i * 8192, R, C); const int Rb = Epi::PERM ? ((R & ~31) + perm32(R & 31)) : R;
        vA[0][i] = (unsigned)(R * lda + C) * 2u; vA[1][i] = vA[0][i] + (unsigned)hstepA; voffB[i] = (unsigned)(Rb * K + C) * 2u; }
#define PG8_LOADVA(dst, pm_) do { int t2_ = tid; asm volatile("" : "+v"(t2_)); _Pragma("unroll") for (int i_ = 0; i_ < 2; ++i_) { int R_, C_; stage_rc(t2_ * 16 + i_ * 8192, R_, C_); \
        _Pragma("unroll") for (int h_ = 0; h_ < 2; ++h_) dst[h_][i_] = (unsigned)rowtok[(pm_) * 256 + 128 * h_ + R_] * (unsigned)(lda * 2) + (unsigned)(C_ * 2); } } while (0)
    const unsigned ldsw = (unsigned)wid * 1024u;
    const int aoff = lds_byte(wr * 64 + fr, fq * 8), boff = lds_byte(wc * 32 + fr, fq * 8);
#define PG8_SA(b, h) (((b) * 2 + (h)) * HTB)
#define PG8_SB(b, h) ((4 + (b) * 2 + (h)) * HTB)
#define PG8_STAGE(bufoff, gbase, voff) do { _Pragma("unroll") for (int _i = 0; _i < 2; ++_i) \
        __builtin_amdgcn_global_load_lds((const unsigned*)((const char*)(gbase) + (voff)[_i]), (LAS unsigned*)(lds + (bufoff) + ldsw + _i * 8192), 16, 0, 0); } while (0)
#define PG8_LDA(dst, b, h) do { _Pragma("unroll") for (int m = 0; m < 4; ++m) _Pragma("unroll") for (int k = 0; k < 2; ++k) dst[m][k] = *(const LAS bf16x8*)(lds + PG8_SA(b, h) + aoff + m * 2048 + k * 1024); } while (0)
#define PG8_LDB(dst, b, h) do { _Pragma("unroll") for (int n = 0; n < 2; ++n) _Pragma("unroll") for (int k = 0; k < 2; ++k) dst[n][k] = *(const LAS bf16x8*)(lds + PG8_SB(b, h) + boff + n * 2048 + k * 1024); } while (0)
#define PG8_MMA(ai, bj, At, Bt) do { __builtin_amdgcn_s_setprio(1); _Pragma("unroll") for (int m = 0; m < 4; ++m) _Pragma("unroll") for (int n = 0; n < 2; ++n) _Pragma("unroll") for (int k = 0; k < 2; ++k) \
        acc[ai][bj][m][n] = __builtin_amdgcn_mfma_f32_16x16x32_bf16(Bt[n][k], At[m][k], acc[ai][bj][m][n], 0, 0, 0); __builtin_amdgcn_s_setprio(0); } while (0)
#define PG8_WAIT_V(n) asm volatile("s_waitcnt vmcnt(" #n ")" ::: "memory")
#define PG8_WAIT_L(n) asm volatile("s_waitcnt lgkmcnt(" #n ")" ::: "memory")
#define PG8_BAR __builtin_amdgcn_s_barrier()
#define PG8_SCHED __builtin_amdgcn_sched_barrier(0)
    Unit cur, nxt; int ui = 0;
    if (!S.next(0, cur)) return;
    f32x4 acc[2][2][4][2];
#pragma unroll
    for (int a = 0; a < 2; ++a)
#pragma unroll
        for (int b = 0; b < 2; ++b)
#pragma unroll
            for (int m = 0; m < 4; ++m)
#pragma unroll
                for (int n = 0; n < 2; ++n) acc[a][b][m][n] = (f32x4){0.f, 0.f, 0.f, 0.f};
    bf16x8 At[4][2], B0[2][2], B1[2][2];
    const char* cA = (const char*)g.A + (size_t)cur.pm * tstepA; const char* cB = (const char*)g.Bt + (size_t)cur.pb * tstepB;
    if constexpr (GATHER) { PG8_LOADVA(vA, cur.pm); }
    PG8_STAGE(PG8_SB(0, 0), cB, voffB); PG8_STAGE(PG8_SB(0, 1), cB + hstepB, voffB); PG8_STAGE(PG8_SA(0, 0), cA, vA[0]); PG8_STAGE(PG8_SA(0, 1), cA, vA[1]);
    if (wr == 1) PG8_BAR;
    PG8_WAIT_V(2); PG8_BAR;
    PG8_STAGE(PG8_SB(1, 0), cB + kstep, voffB); PG8_STAGE(PG8_SA(1, 0), cA + kstep, vA[0]); PG8_STAGE(PG8_SB(1, 1), cB + hstepB + kstep, voffB);
    PG8_WAIT_V(6); PG8_BAR;
    for (;;) {
        const bool has_next = S.next(ui + 1, nxt);
        const char* nA = has_next ? (const char*)g.A + (size_t)nxt.pm * tstepA : cA + (size_t)(nt - 2) * kstep; const char* nB = has_next ? (const char*)g.Bt + (size_t)nxt.pb * tstepB : cB + (size_t)(nt - 2) * kstep;
        if constexpr (GATHER) { if (has_next && wid < 4)
            __builtin_amdgcn_global_load_lds((const unsigned*)(rowtok + nxt.pm * 256 + tid), (LAS unsigned*)(gtab + wid * 64), 4, 0, 0); }
        for (int t = 0; t < nt; t += 2) {
            const bool last = (t == nt - 2);
            const char* a1 = cA + (size_t)(t + 1) * kstep;
            const char* a2 = last ? nA : cA + (size_t)(t + 2) * kstep; const char* b2 = last ? nB : cB + (size_t)(t + 2) * kstep;
            const char* a3 = a2 + kstep; const char* b3 = b2 + kstep;
            if constexpr (Epi::MIDK) { if (t == Epi::MID_T) { if (ALIGN_EPI && wr == 0) PG8_BAR; int fr2 = fr, fq2 = fq; asm volatile("" : "+v"(fr2), "+v"(fq2)); E.mid(acc, cur, wr, wc, fr2, fq2); if (ALIGN_EPI && wr == 1) PG8_BAR; } }
            PG8_LDB(B0, 0, 0); PG8_LDB(B1, 0, 1); PG8_SCHED; PG8_LDA(At, 0, 0); PG8_STAGE(PG8_SA(1, 1), a1, vA[1]);
            if constexpr (GATHER) { if (last && has_next) { int t2_ = tid; asm volatile("" : "+v"(t2_));
#pragma unroll
                for (int i_ = 0; i_ < 2; ++i_) { int R_, C_; stage_rc(t2_ * 16 + i_ * 8192, R_, C_);
                    vA[0][i_] = (unsigned)gtab[R_] * (unsigned)(lda * 2) + (unsigned)(C_ * 2); vA[1][i_] = (unsigned)gtab[128 + R_] * (unsigned)(lda * 2) + (unsigned)(C_ * 2); } } }
            PG8_WAIT_V(8); PG8_WAIT_L(0); PG8_BAR; PG8_MMA(0, 0, At, B0); PG8_MMA(0, 1, At, B1); PG8_BAR; PG8_SCHED;
            PG8_LDA(At, 0, 1); PG8_STAGE(PG8_SB(0, 0), b2, voffB); PG8_STAGE(PG8_SB(0, 1), b2 + hstepB, voffB); PG8_STAGE(PG8_SA(0, 0), a2, vA[0]);
            PG8_WAIT_V(8); PG8_WAIT_L(0); PG8_BAR; PG8_MMA(1, 0, At, B0); PG8_MMA(1, 1, At, B1); PG8_BAR; PG8_SCHED;
            PG8_LDB(B0, 1, 0); PG8_LDB(B1, 1, 1); PG8_SCHED; PG8_LDA(At, 1, 0); PG8_STAGE(PG8_SA(0, 1), a2, vA[1]);
            PG8_WAIT_V(8); PG8_WAIT_L(0); PG8_BAR; PG8_MMA(0, 0, At, B0); PG8_MMA(0, 1, At, B1); PG8_BAR; PG8_SCHED;
            PG8_LDA(At, 1, 1); PG8_STAGE(PG8_SB(1, 0), b3, voffB); PG8_STAGE(PG8_SB(1, 1), b3 + hstepB, voffB); PG8_STAGE(PG8_SA(1, 0), a3, vA[0]);
            PG8_WAIT_V(8); PG8_WAIT_L(0); PG8_BAR; PG8_MMA(1, 0, At, B0); PG8_MMA(1, 1, At, B1); PG8_BAR; PG8_SCHED;
        }
        if constexpr (ALIGN_EPI) { if (wr == 0) PG8_BAR; }
        { int fr2 = fr, fq2 = fq; asm volatile("" : "+v"(fr2), "+v"(fq2)); E(acc, cur, wr, wc, fr2, fq2); }
        if (!has_next) break;
#pragma unroll
        for (int a = 0; a < 2; ++a)
#pragma unroll
            for (int b = 0; b < 2; ++b)
#pragma unroll
                for (int m = 0; m < 4; ++m)
#pragma unroll
                    for (int n = 0; n < 2; ++n) acc[a][b][m][n] = (f32x4){0.f, 0.f, 0.f, 0.f};
        cur = nxt; cA = nA; cB = nB; ++ui;
        if constexpr (ALIGN_EPI) { if (wr == 1) PG8_BAR; }
    }
    PG8_WAIT_V(0);
    if constexpr (!ALIGN_EPI) { if (wr == 0) PG8_BAR; }
    PG8_BAR;
#undef PG8_LOADVA
#undef PG8_SA
#undef PG8_SB
#undef PG8_STAGE
#undef PG8_LDA
#undef PG8_LDB
#undef PG8_MMA
#undef PG8_WAIT_V
#undef PG8_WAIT_L
#undef PG8_BAR
#undef PG8_SCHED
}

typedef f32x4 Acc[2][2][4][2];
__device__ __forceinline__ u32x4 pack8(const f32x4 a, const f32x4 b) { u32x4 w; w.x = cvt_pk_bf16(a[0], a[1]); w.y = cvt_pk_bf16(a[2], a[3]); w.z = cvt_pk_bf16(b[0], b[1]); w.w = cvt_pk_bf16(b[2], b[3]); return w; }
__device__ __forceinline__ void unpack8(const u32x4 w, f32x4& a, f32x4& b) {
    a[0] = __uint_as_float(w.x << 16); a[1] = __uint_as_float(w.x & 0xffff0000u); a[2] = __uint_as_float(w.y << 16); a[3] = __uint_as_float(w.y & 0xffff0000u);
    b[0] = __uint_as_float(w.z << 16); b[1] = __uint_as_float(w.z & 0xffff0000u); b[2] = __uint_as_float(w.w << 16); b[3] = __uint_as_float(w.w & 0xffff0000u); }

struct EpiProj {
    static constexpr bool PERM = true, MIDK = false; static constexpr int MID_T = 0;
    bf16_t* Q; bf16_t* KV; bf16_t* U; float* GT; bf16_t* RATIO; bf16_t* S1;
    __device__ __forceinline__ void mid(Acc&, const Unit&, int, int, int, int) const {}
    __device__ __forceinline__ void operator()(const Acc& acc, const Unit& u, int wr, int wc, int fr, int fq) const {
        const int row0 = u.pm * BM + wr * 64 + fr, pn = u.pn;
        if (pn < 7) {
            bf16_t* b0; size_t bstep; int ld; float sc = 1.0f; const int lc = wc * 32 + 8 * fq;
            if (pn < 2) { b0 = Q + pn * 256 + lc; bstep = 128; ld = 512; sc = 0.125f * 1.4426950408889634f; }
            else if (pn < 5) { const int gg = wc >> 1, d = (wc & 1) * 32 + 8 * fq; b0 = KV + ((size_t)((2 * (pn - 2)) * 2 + gg) * T_) * 64 + d; bstep = (size_t)2 * T_ * 64; ld = 64; }
            else { b0 = U + (pn - 5) * 256 + lc; bstep = 128; ld = 512; }
#pragma unroll
            for (int ai = 0; ai < 2; ++ai)
#pragma unroll
                for (int m = 0; m < 4; ++m) { bf16_t* rp = b0 + (size_t)(row0 + ai * HALF + m * 16) * ld;
                    *(u32x4*)(rp) = pack8(acc[ai][0][m][0] * sc, acc[ai][0][m][1] * sc); *(u32x4*)(rp + bstep) = pack8(acc[ai][1][m][0] * sc, acc[ai][1][m][1] * sc); }
        } else if (pn < 15) {
#pragma unroll
            for (int ai = 0; ai < 2; ++ai)
#pragma unroll
                for (int m = 0; m < 4; ++m) {
                    f32x4 r0, r1, s0, s1;
#pragma unroll
                    for (int j = 0; j < 4; ++j) {
                        { const float l0 = fminf(fmaxf(acc[ai][0][m][0][j], -30.f), 30.f), l1 = fminf(fmaxf(acc[ai][1][m][0][j], -30.f), 30.f);
                          const float e0 = 1.0f + fexpn(l0), e1 = 1.0f + fexpn(l1); r0[j] = e1 * frcp(e0); s0[j] = frcp(e1); }
                        { const float l0 = fminf(fmaxf(acc[ai][0][m][1][j], -30.f), 30.f), l1 = fminf(fmaxf(acc[ai][1][m][1][j], -30.f), 30.f);
                          const float e0 = 1.0f + fexpn(l0), e1 = 1.0f + fexpn(l1); r1[j] = e1 * frcp(e0); s1[j] = frcp(e1); }
                    }
                    const size_t o = ((((size_t)(u.pm * 8 + pn - 7) * 8 + wr * 4 + wc) * 8 + ai * 4 + m) * 64 + fq * 16 + fr) * 8;
                    *(u32x4*)(RATIO + o) = pack8(r0, r1); *(u32x4*)(S1 + o) = pack8(s0, s1);
                }
        } else {
            if (wc == 0 && fq < 3) {
#pragma unroll
                for (int ai = 0; ai < 2; ++ai)
#pragma unroll
                    for (int m = 0; m < 4; ++m) { f32x4 a, b;
#pragma unroll
                        for (int j = 0; j < 4; ++j) { a[j] = sigmoidf_(acc[ai][0][m][0][j]); b[j] = sigmoidf_(acc[ai][0][m][1][j]); }
                        float* gp = GT + (size_t)(row0 + ai * HALF + m * 16) * 32 + 8 * fq; *(f32x4*)(gp) = a; *(f32x4*)(gp + 4) = b; }
            }
        }
    }
};
struct EpiCmpH {
    static constexpr bool PERM = true, MIDK = false; static constexpr int MID_T = 0;
    bf16_t* HC; const float* bias;
    __device__ __forceinline__ void mid(Acc&, const Unit&, int, int, int, int) const {}
    __device__ __forceinline__ void operator()(const Acc& acc, const Unit& u, int wr, int wc, int fr, int fq) const {
        const int row0 = u.pm * BM + wr * 64 + fr; const float* bp = bias + u.pb * 256;
#pragma unroll
        for (int bj = 0; bj < 2; ++bj) { const int c0 = bj * 128 + wc * 32 + 8 * fq; const f32x4 b0 = *(const f32x4*)(bp + c0), b1 = *(const f32x4*)(bp + c0 + 4);
#pragma unroll
            for (int ai = 0; ai < 2; ++ai)
#pragma unroll
                for (int m = 0; m < 4; ++m) { f32x4 x0 = acc[ai][bj][m][0] + b0, x1 = acc[ai][bj][m][1] + b1;
#pragma unroll
                    for (int j = 0; j < 4; ++j) { const float a = x0[j], b = x1[j];
                        x0[j] = a * frcp(1.0f + fexpn(1.5957691216f * (a + 0.044715f * a * a * a)));
                        x1[j] = b * frcp(1.0f + fexpn(1.5957691216f * (b + 0.044715f * b * b * b))); }
                    *(u32x4*)(HC + (size_t)(row0 + ai * HALF + m * 16) * 256 + c0) = pack8(x0, x1); } }
    }
};
struct EpiMerge {
    static constexpr bool PERM = true, MIDK = true; static constexpr int MID_T = 8;
    const bf16_t* RATIO; const bf16_t* S1; bf16_t* OUT;
    __device__ __forceinline__ size_t gimg(int row0, int col0, int bj) const { const int pm = row0 >> 8, wr = (row0 >> 6) & 1, fr = row0 & 15, pn = col0 >> 8, wc = (col0 >> 5) & 3, fq = (col0 >> 3) & 3;
        return ((((size_t)(pm * 8 + 2 * pn + bj) * 8 + wr * 4 + wc) * 8) * 64 + fq * 16 + fr) * 8; }
    __device__ __forceinline__ void load8(const bf16_t* P, int row0, int col0, int ai, u32x4 (&w)[8]) const {
#pragma unroll
        for (int m = 0; m < 4; ++m)
#pragma unroll
            for (int bj = 0; bj < 2; ++bj) w[m * 2 + bj] = *(const u32x4*)(P + gimg(row0, col0, bj) + (ai * 4 + m) * 512);
        asm volatile("" : "+v"(w[0]), "+v"(w[1]), "+v"(w[2]), "+v"(w[3]), "+v"(w[4]), "+v"(w[5]), "+v"(w[6]), "+v"(w[7]));
    }
    __device__ __forceinline__ void mid(Acc& acc, const Unit& u, int wr, int wc, int fr, int fq) const {
        const int row0 = u.pm * BM + wr * 64 + fr, col0 = u.pn * BM + wc * 32 + 8 * fq;
        u32x4 w0[8], w1[8];
#pragma unroll
        for (int m = 0; m < 4; ++m)
#pragma unroll
            for (int bj = 0; bj < 2; ++bj) { w0[m * 2 + bj] = *(const u32x4*)(RATIO + gimg(row0, col0, bj) + m * 512); w1[m * 2 + bj] = *(const u32x4*)(RATIO + gimg(row0, col0, bj) + (4 + m) * 512); }
        asm volatile("" : "+v"(w0[0]), "+v"(w0[1]), "+v"(w0[2]), "+v"(w0[3]), "+v"(w0[4]), "+v"(w0[5]), "+v"(w0[6]), "+v"(w0[7]));
        asm volatile("" : "+v"(w1[0]), "+v"(w1[1]), "+v"(w1[2]), "+v"(w1[3]), "+v"(w1[4]), "+v"(w1[5]), "+v"(w1[6]), "+v"(w1[7]));
#pragma unroll
        for (int m = 0; m < 4; ++m)
#pragma unroll
            for (int bj = 0; bj < 2; ++bj) { f32x4 a, b; unpack8(w0[m * 2 + bj], a, b); acc[0][bj][m][0] *= a; acc[0][bj][m][1] *= b; unpack8(w1[m * 2 + bj], a, b); acc[1][bj][m][0] *= a; acc[1][bj][m][1] *= b; }
    }
    __device__ __forceinline__ void operator()(const Acc& acc, const Unit& u, int wr, int wc, int fr, int fq) const {
        const int row0 = u.pm * BM + wr * 64 + fr, col0 = u.pn * BM + wc * 32 + 8 * fq;
#pragma unroll
        for (int ai = 0; ai < 2; ++ai) { u32x4 w[8]; load8(S1, row0, col0, ai, w);
#pragma unroll
            for (int m = 0; m < 4; ++m)
#pragma unroll
                for (int bj = 0; bj < 2; ++bj) { const size_t o = (size_t)(row0 + ai * HALF + m * 16) * 1024 + col0 + bj * HALF; f32x4 a, b; unpack8(w[m * 2 + bj], a, b);
                    *(u32x4*)(OUT + o) = pack8(acc[ai][bj][m][0] * a, acc[ai][bj][m][1] * b); } }
    }
};
struct EpiResid {
    static constexpr bool PERM = true, MIDK = false; static constexpr int MID_T = 0;
    const void* hin; bf16_t* hout; bool in_f32;
    __device__ __forceinline__ void mid(Acc&, const Unit&, int, int, int, int) const {}
    __device__ __forceinline__ void operator()(const Acc& acc, const Unit& u, int wr, int wc, int fr, int fq) const {
        const int row0 = u.pm * BM + wr * 64 + fr, col0 = u.pn * BM + wc * 32 + 8 * fq;
        if (in_f32) {
#pragma unroll
            for (int ai = 0; ai < 2; ++ai)
#pragma unroll
                for (int mh = 0; mh < 2; ++mh) { f32x4 w[8];
#pragma unroll
                    for (int m2 = 0; m2 < 2; ++m2)
#pragma unroll
                        for (int bj = 0; bj < 2; ++bj) { const size_t off = (size_t)(row0 + ai * HALF + (mh * 2 + m2) * 16) * 1024 + col0 + bj * HALF; w[(m2 * 2 + bj) * 2] = *(const f32x4*)((const float*)hin + off); w[(m2 * 2 + bj) * 2 + 1] = *(const f32x4*)((const float*)hin + off + 4); }
                    asm volatile("" : "+v"(w[0]), "+v"(w[1]), "+v"(w[2]), "+v"(w[3]), "+v"(w[4]), "+v"(w[5]), "+v"(w[6]), "+v"(w[7]));
#pragma unroll
                    for (int m2 = 0; m2 < 2; ++m2)
#pragma unroll
                        for (int bj = 0; bj < 2; ++bj) { const int m = mh * 2 + m2; const size_t off = (size_t)(row0 + ai * HALF + m * 16) * 1024 + col0 + bj * HALF;
                            *(u32x4*)(hout + off) = pack8(w[(m2 * 2 + bj) * 2] + acc[ai][bj][m][0], w[(m2 * 2 + bj) * 2 + 1] + acc[ai][bj][m][1]); } }
        } else { u32x4 w0[8], w1[8];
            bf16_t* hb = hout + (size_t)row0 * 1024 + col0;
#pragma unroll
            for (int m = 0; m < 4; ++m)
#pragma unroll
                for (int bj = 0; bj < 2; ++bj) { w0[m * 2 + bj] = *(const u32x4*)(hb + (m * 16) * 1024 + bj * HALF); w1[m * 2 + bj] = *(const u32x4*)(hb + (HALF + m * 16) * 1024 + bj * HALF); }
            asm volatile("" : "+v"(w0[0]), "+v"(w0[1]), "+v"(w0[2]), "+v"(w0[3]), "+v"(w0[4]), "+v"(w0[5]), "+v"(w0[6]), "+v"(w0[7]));
            asm volatile("" : "+v"(w1[0]), "+v"(w1[1]), "+v"(w1[2]), "+v"(w1[3]), "+v"(w1[4]), "+v"(w1[5]), "+v"(w1[6]), "+v"(w1[7]));
#pragma unroll
            for (int ai = 0; ai < 2; ++ai)
#pragma unroll
                for (int m = 0; m < 4; ++m)
#pragma unroll
                    for (int bj = 0; bj < 2; ++bj) { f32x4 a, b; unpack8(ai ? w1[m * 2 + bj] : w0[m * 2 + bj], a, b);
                        *(u32x4*)(hb + (ai * HALF + m * 16) * 1024 + bj * HALF) = pack8(a + acc[ai][bj][m][0], b + acc[ai][bj][m][1]); }
        }
    }
};
struct EpiSwiglu {
    static constexpr bool PERM = true, MIDK = false; static constexpr int MID_T = 0;
    bf16_t* H; int ldh;
    __device__ __forceinline__ void mid(Acc&, const Unit&, int, int, int, int) const {}
    __device__ __forceinline__ void operator()(const Acc& acc, const Unit& u, int wr, int wc, int fr, int fq) const {
        const int row0 = u.pm * BM + wr * 64 + fr, col0 = u.pn * 128 + wc * 32 + 8 * fq;
#pragma unroll
        for (int ai = 0; ai < 2; ++ai)
#pragma unroll
            for (int m = 0; m < 4; ++m) { f32x4 x0, x1;
#pragma unroll
                for (int j = 0; j < 4; ++j) { const float g0 = acc[ai][0][m][0][j], g1 = acc[ai][0][m][1][j];
                    x0[j] = g0 * frcp(1.0f + fexpn(g0)) * acc[ai][1][m][0][j]; x1[j] = g1 * frcp(1.0f + fexpn(g1)) * acc[ai][1][m][1][j]; }
                *(u32x4*)(H + (size_t)(row0 + ai * HALF + m * 16) * ldh + col0) = pack8(x0, x1); }
    }
};
struct EpiScatter {
    static constexpr bool PERM = true, MIDK = false; static constexpr int MID_T = 0;
    bf16_t* YB; const int* row_dst;
    __device__ __forceinline__ void mid(Acc&, const Unit&, int, int, int, int) const {}
    __device__ __forceinline__ void operator()(const Acc& acc, const Unit& u, int wr, int wc, int fr, int fq) const {
        const int row0 = u.pm * BM + wr * 64 + fr, col0 = u.pn * BM + wc * 32 + 8 * fq;
        int dst[8];
#pragma unroll
        for (int ai = 0; ai < 2; ++ai)
#pragma unroll
            for (int m = 0; m < 4; ++m) dst[ai * 4 + m] = row_dst[row0 + ai * HALF + m * 16];
        asm volatile("" : "+v"(dst[0]), "+v"(dst[1]), "+v"(dst[2]), "+v"(dst[3]), "+v"(dst[4]), "+v"(dst[5]), "+v"(dst[6]), "+v"(dst[7]));
#pragma unroll
        for (int ai = 0; ai < 2; ++ai)
#pragma unroll
            for (int m = 0; m < 4; ++m) {
#pragma unroll
                for (int bj = 0; bj < 2; ++bj) *(u32x4*)(YB + (size_t)dst[ai * 4 + m] * 1024 + col0 + bj * HALF) = pack8(acc[ai][bj][m][0], acc[ai][bj][m][1]); }
    }
};
}

struct Params {
    const float* x; const float* norm_mix_g; const float* w_in; const float* cmp_pos; const float* cmp_w1; const float* cmp_w2; const float* w_nsa_up;
    const float* pool_w; const float* pool_scale; const float* w_pool_up; const float* w_out; const float* norm_ffn_g;
    const float* ffn_w_gate; const float* ffn_w_up; const float* ffn_w_down; const float* moe_w_router; const float* moe_b_router;
    const float* moe_w_gate; const float* moe_w_up; const float* moe_w_down; const float* final_norm_g;
    float* out; unsigned char* ws;
    int ph_lo, ph_hi;
};

__device__ __forceinline__ void load_params(Params& p) {
#if defined(__HIP_DEVICE_COMPILE__)
    typedef const __attribute__((address_space(4))) unsigned long long* cptr_t;
    typedef __attribute__((address_space(1))) const float* gcf; typedef __attribute__((address_space(1))) float* gf; typedef __attribute__((address_space(1))) unsigned char* guc;
    cptr_t q = (cptr_t)__builtin_amdgcn_kernarg_segment_ptr(); asm volatile("" : "+s"(q));
    p.x = (const float*)(gcf)q[0];
    p.norm_mix_g = (const float*)(gcf)q[1];
    p.w_in = (const float*)(gcf)q[2];
    p.cmp_pos = (const float*)(gcf)q[3];
    p.cmp_w1 = (const float*)(gcf)q[4];
    p.cmp_w2 = (const float*)(gcf)q[5];
    p.w_nsa_up = (const float*)(gcf)q[6];
    p.pool_w = (const float*)(gcf)q[7];
    p.pool_scale = (const float*)(gcf)q[8];
    p.w_pool_up = (const float*)(gcf)q[9];
    p.w_out = (const float*)(gcf)q[10];
    p.norm_ffn_g = (const float*)(gcf)q[11];
    p.ffn_w_gate = (const float*)(gcf)q[12];
    p.ffn_w_up = (const float*)(gcf)q[13];
    p.ffn_w_down = (const float*)(gcf)q[14];
    p.moe_w_router = (const float*)(gcf)q[15];
    p.moe_b_router = (const float*)(gcf)q[16];
    p.moe_w_gate = (const float*)(gcf)q[17];
    p.moe_w_up = (const float*)(gcf)q[18];
    p.moe_w_down = (const float*)(gcf)q[19];
    p.final_norm_g = (const float*)(gcf)q[20];
    p.out = (float*)(gf)q[21]; p.ws = (unsigned char*)(guc)q[22];
    { const unsigned long long w = q[23]; p.ph_lo = (int)(unsigned)w; p.ph_hi = (int)(unsigned)(w >> 32); }
#endif
}
__device__ __forceinline__ unsigned char* launder_ws(unsigned char* w) {
    unsigned long long v = (unsigned long long)w; asm volatile("" : "+s"(v)); return (unsigned char*)(__attribute__((address_space(1))) unsigned char*)v; }
__device__ __forceinline__ XcdBarrier relaunder_bar(const XcdBarrier& b) {
    unsigned long long pb = (unsigned long long)b.bar; unsigned x = b.x; unsigned st = (unsigned)(unsigned long long)(uintptr_t)b.st;
    asm volatile("" : "+s"(pb), "+s"(x), "+s"(st));
    XcdBarrier r; r.bar = (unsigned*)(__attribute__((address_space(1))) unsigned*)pb; r.x = x; r.st = (volatile LAS unsigned*)(uintptr_t)st; return r; }
constexpr int NTHR = 512, NWAVES = 8;
constexpr int RING_BYTES = 131072, MISC_OFF = RING_BYTES, LDS_BYTES = 147456;

struct Ctx { LAS unsigned char* lds; int tid, lane, wave, G, bid; };

__device__ __forceinline__ void tconv_tile(const Ctx& F, const float* src, int ld, int col0, int nvalid, int k0, bf16_t* dst, int ldd, int r0, int kd0) {
    LAS float* tile = (LAS float*)(F.lds + F.wave * 8704);
    const int lane = F.lane, kq = lane >> 3, c4 = (lane & 7) * 4;
    f32x4 v[8];
#pragma unroll
    for (int i = 0; i < 8; ++i) { const float* sp = src + (size_t)(k0 + kq + 8 * i) * ld + col0 + c4;
        if (c4 + 3 < nvalid) v[i] = *(const f32x4*)sp;
        else { v[i][0] = (c4 < nvalid) ? sp[0] : 0.f; v[i][1] = (c4 + 1 < nvalid) ? sp[1] : 0.f; v[i][2] = (c4 + 2 < nvalid) ? sp[2] : 0.f; v[i][3] = 0.f; } }
    LDS_FENCE();
#pragma unroll
    for (int i = 0; i < 8; ++i)
#pragma unroll
        for (int j = 0; j < 4; ++j) tile[(c4 + j) * 68 + kq + 8 * i] = v[i][j];
    LDS_FENCE();
    { const int c = lane >> 1, kh = (lane & 1) * 32; u32x4 w[4];
#pragma unroll
      for (int q = 0; q < 4; ++q) { const f32x4 a = *(const LAS f32x4*)(tile + c * 68 + kh + q * 8), b = *(const LAS f32x4*)(tile + c * 68 + kh + q * 8 + 4); w[q] = pg8::pack8(a, b); }
      bf16_t* dp = dst + (size_t)(r0 + c) * ldd + kd0 + k0 + kh;
#pragma unroll
      for (int q = 0; q < 4; ++q) *(u32x4*)(dp + q * 8) = w[q]; }
}
template <class Fn>
__device__ __forceinline__ void tconv_matrix(const Ctx& F, int nrow_tiles, int K, bf16_t* dst, int ldd, int kd0, int& wcur, Fn fn) {
    const int nk = K / 64, ntiles = nrow_tiles * nk, NW = F.G * NWAVES, me = F.bid * NWAVES + F.wave;
    int first = (me - (wcur % NW) + NW) % NW;
    for (int i = first; i < ntiles; i += NW) { const int rt = i % nrow_tiles, kt = i / nrow_tiles;   const float* src; int ld, col0, nvalid; fn(rt, src, ld, col0, nvalid);
        tconv_tile(F, src, ld, col0, nvalid, kt * 64, dst, ldd, rt * 32, kd0); }
    wcur += ntiles;
}

__device__ __forceinline__ void phase_prep_mixer(const Ctx& F, const Params& p, int L, int part = 3) {
    unsigned char* ws = p.ws; int wcur = 0;
    if (part & 1) {
    { const float* base = p.w_in + (size_t)L * 1024 * INC_;
      tconv_matrix(F, 128, 1024, (bf16_t*)(ws + W_IN_(L)), 1024, 0, wcur, [&](int rt, const float*& src, int& ld, int& col0, int& nvalid) {
          const int r0 = rt * 32; src = base; ld = INC_; nvalid = 32;
          if (r0 < 1280) col0 = r0;
          else if (r0 < 1792) col0 = 1304 + (r0 - 1280);
          else if (r0 < 3840) { const int loc = r0 - 1792, q8 = loc >> 8, within = loc & 255, half = within >> 7, i = within & 127; col0 = 1816 + half * 1024 + q8 * 128 + i; }
          else if (r0 == 3840) { col0 = 1280; nvalid = 24; }
          else { col0 = 0; nvalid = 0; } }); }
    { const float* base = p.cmp_w1 + (size_t)L * 2 * 2048 * 256;
      tconv_matrix(F, 16, 2048, (bf16_t*)(ws + W_C1_(L)), 2048, 0, wcur, [&](int rt, const float*& src, int& ld, int& col0, int& nvalid) {
          src = base + (size_t)(rt >> 3) * 2048 * 256; ld = 256; col0 = (rt & 7) * 32; nvalid = 32; }); }
    { const float* base = p.w_nsa_up + (size_t)L * 512 * 1024;
      tconv_matrix(F, 32, 512, (bf16_t*)(ws + W_M_(L)), 1024, 0, wcur, [&](int rt, const float*& src, int& ld, int& col0, int& nvalid) { src = base; ld = 1024; col0 = rt * 32; nvalid = 32; }); }
    { const float* base = p.w_out + (size_t)L * 1024 * 1024;
      tconv_matrix(F, 32, 1024, (bf16_t*)(ws + W_O_(L)), 1024, 0, wcur, [&](int rt, const float*& src, int& ld, int& col0, int& nvalid) { src = base; ld = 1024; col0 = rt * 32; nvalid = 32; }); }
    }
    if (!(part & 2)) return;
    if (F.bid >= F.G - 16) { const int wq = F.bid - (F.G - 16), kv = wq >> 3, cb = (wq & 7) * 32, c = F.tid & 31, kg = F.tid >> 5;
        const float* pos = p.cmp_pos + (size_t)(L * 2 + kv) * 2048; const float* w1 = p.cmp_w1 + (size_t)(L * 2 + kv) * 2048 * 256 + cb + c; float s = 0.f;
#pragma unroll 32
        for (int j = 0; j < 128; ++j) { const int k = kg + 16 * j; s += pos[k] * w1[(size_t)k * 256]; }
        LAS float* red = (LAS float*)(F.lds + 73728); red[F.tid] = s; __syncthreads();
        if (F.tid < 32) { float t = 0.f;
#pragma unroll
            for (int q = 0; q < 16; ++q) t += red[q * 32 + F.tid];
            ((float*)(ws + W_B1_(L)))[kv * 256 + cb + F.tid] = t; }
        __syncthreads(); }
    if (F.bid < 64) { const int g = F.bid >> 4, c0 = (F.bid & 15) * 8; const float* pw = p.pool_w + (size_t)L * 4 * 128 * 128 + (size_t)(g * 128 + c0) * 128; const float* ps = p.pool_scale + (size_t)L * 512 + g * 128;
        const float* wp = p.w_pool_up + (size_t)L * 512 * 1024 + (size_t)(g * 128) * 1024 + F.tid * 2; bf16_t* wm = (bf16_t*)(ws + W_M_(L));
        LAS float* al = (LAS float*)(F.lds + 73728);
        for (int i = F.tid; i < 1024; i += NTHR) { const int d = i >> 3, cc = i & 7; al[i] = pw[cc * 128 + d] * ps[d]; }
        __syncthreads();
        f32x2 acc[8];
#pragma unroll
        for (int cc = 0; cc < 8; ++cc) acc[cc] = (f32x2){0.f, 0.f};
#pragma unroll 16
        for (int d = 0; d < 128; ++d) { const f32x2 w = *(const f32x2*)(wp + (size_t)d * 1024); const f32x4 a0 = *(const LAS f32x4*)(al + d * 8), a1 = *(const LAS f32x4*)(al + d * 8 + 4);
            acc[0] += w * a0[0]; acc[1] += w * a0[1]; acc[2] += w * a0[2]; acc[3] += w * a0[3]; acc[4] += w * a1[0]; acc[5] += w * a1[1]; acc[6] += w * a1[2]; acc[7] += w * a1[3]; }
#pragma unroll
        for (int i = 0; i < 2; ++i) { u32x4 o; o.x = cvt_pk_bf16(acc[0][i], acc[1][i]); o.y = cvt_pk_bf16(acc[2][i], acc[3][i]); o.z = cvt_pk_bf16(acc[4][i], acc[5][i]); o.w = cvt_pk_bf16(acc[6][i], acc[7][i]);
            *(u32x4*)(wm + (size_t)(F.tid * 2 + i) * 1024 + 512 + g * 128 + c0) = o; }
        __syncthreads(); }
}

__device__ __forceinline__ void phase_prep_ffn(const Ctx& F, const Params& p, int L) {
    unsigned char* ws = p.ws; int wcur = 0;
    const int j = L >> 1;
    if ((L & 1) == 0) {
        const float* wg = p.ffn_w_gate + (size_t)j * 1024 * DFF_; const float* wu = p.ffn_w_up + (size_t)j * 1024 * DFF_; const float* wd = p.ffn_w_down + (size_t)j * DFF_ * 1024;
        tconv_matrix(F, 2 * DFF_ / 32, 1024, (bf16_t*)(ws + W_FF), 1024, 0, wcur, [&](int rt, const float*& src, int& ld, int& col0, int& nvalid) {
            const int r0 = rt * 32, pn = r0 >> 8, within = r0 & 255, half = within >> 7, i = within & 127; src = half ? wu : wg; ld = DFF_; col0 = pn * 128 + i; nvalid = 32; });
        tconv_matrix(F, 32, DFF_, (bf16_t*)(ws + W_FFD_DENSE), DFF_, 0, wcur, [&](int rt, const float*& src, int& ld, int& col0, int& nvalid) { src = wd; ld = 1024; col0 = rt * 32; nvalid = 32; });
    } else {
        const float* wg = p.moe_w_gate + (size_t)j * NE_ * 1024 * DFE_; const float* wu = p.moe_w_up + (size_t)j * NE_ * 1024 * DFE_; const float* wd = p.moe_w_down + (size_t)j * NE_ * DFE_ * 1024;
        constexpr int RT_E = 2 * DFE_ / 32;
        tconv_matrix(F, NE_ * RT_E, 1024, (bf16_t*)(ws + W_FF), 1024, 0, wcur, [&](int rt, const float*& src, int& ld, int& col0, int& nvalid) {
            const int e = rt / RT_E, r0 = (rt % RT_E) * 32, pn = r0 >> 8, within = r0 & 255, half = within >> 7, i = within & 127;
            src = (half ? wu : wg) + (size_t)e * 1024 * DFE_; ld = DFE_; col0 = pn * 128 + i; nvalid = 32; });
        tconv_matrix(F, NE_ * 32, DFE_, (bf16_t*)(ws + W_FFD_MOE), DFE_, 0, wcur, [&](int rt, const float*& src, int& ld, int& col0, int& nvalid) {
            const int e = rt >> 5; src = wd + (size_t)e * DFE_ * 1024; ld = 1024; col0 = (rt & 31) * 32; nvalid = 32; });
    }
}

__device__ __forceinline__ void phase_norm_b8(const Ctx& F, const bf16_t* h, const float* g, bf16_t* dst) {
    f32x4 gv[4];
#pragma unroll
    for (int i = 0; i < 2; ++i) { gv[2 * i] = *(const f32x4*)(g + i * 512 + F.lane * 8); gv[2 * i + 1] = *(const f32x4*)(g + i * 512 + F.lane * 8 + 4); }
    u32x4 nx[2]; { const int row = F.bid * NWAVES + F.wave; if (row < T_) {
#pragma unroll
        for (int i = 0; i < 2; ++i) nx[i] = *(const u32x4*)(h + (size_t)row * 1024 + i * 512 + F.lane * 8); } }
    for (int row = F.bid * NWAVES + F.wave; row < T_; row += F.G * NWAVES) {
        f32x4 v[4]; float ss = 0.f;
#pragma unroll
        for (int i = 0; i < 2; ++i) pg8::unpack8(nx[i], v[2 * i], v[2 * i + 1]);
        { const int nrow = row + F.G * NWAVES; if (nrow < T_) {
#pragma unroll
            for (int i = 0; i < 2; ++i) nx[i] = *(const u32x4*)(h + (size_t)nrow * 1024 + i * 512 + F.lane * 8); } }
#pragma unroll
        for (int i = 0; i < 4; ++i) ss += v[i][0] * v[i][0] + v[i][1] * v[i][1] + v[i][2] * v[i][2] + v[i][3] * v[i][3];
        ss = wave_sum(ss); const float r = rsqrtf(ss * (1.0f / 1024.0f) + 1e-6f);
#pragma unroll
        for (int i = 0; i < 2; ++i) *(u32x4*)(dst + (size_t)row * 1024 + i * 512 + F.lane * 8) = pg8::pack8(v[2 * i] * r * gv[2 * i], v[2 * i + 1] * r * gv[2 * i + 1]);
    }
}
template <bool HBF> __device__ __forceinline__ f32x4 ld_h4(const void* h, size_t off) {
    if (HBF) { const u32x2 w = *(const u32x2*)((const bf16_t*)h + off); f32x4 v; v[0] = __uint_as_float(w.x << 16); v[1] = __uint_as_float(w.x & 0xffff0000u); v[2] = __uint_as_float(w.y << 16); v[3] = __uint_as_float(w.y & 0xffff0000u); return v; }
    else return *(const f32x4*)((const float*)h + off);
}
template <bool ROUTER, bool HBF>
__device__ __forceinline__ void phase_norm(const Ctx& F, const void* h, const float* g, bf16_t* dst, const float* wrt, const float* brt, int* cnt, int* tok_e, int* tok_p, float* tok_g, int* row_tok, int* row_dst) {
    LAS float* wl = (LAS float*)F.lds;
    LAS int* lcnt = (LAS int*)(F.lds + 32768);
    if (ROUTER) {
        if (F.tid < 8) lcnt[F.tid] = 0;
        for (int i = F.tid; i < 8192; i += NTHR) { const int c = i >> 3, e = i & 7; wl[((((c >> 8) * 4 + (c & 3)) * 2 + (e >> 2)) * 64 + ((c >> 2) & 63)) * 4 + (e & 3)] = wrt[i]; }
        for (int i = F.bid * NTHR + F.tid; i < MOE_ROWS; i += F.G * NTHR) { row_tok[i] = 0; row_dst[i] = YB_DUMMY; }
        __syncthreads();
    }
    f32x4 gv[4];
#pragma unroll
    for (int i = 0; i < 4; ++i) gv[i] = *(const f32x4*)(g + i * 256 + F.lane * 4);
    const bool blk = ROUTER && (T_ % (F.G * NWAVES) == 0); const int rpw = T_ / (F.G * NWAVES);
    const int rstep = blk ? 1 : F.G * NWAVES, rbeg = blk ? (F.bid * NWAVES + F.wave) * rpw : F.bid * NWAVES + F.wave, rend = blk ? rbeg + rpw : T_;
    f32x4 vnx[4]; { const int row = rbeg; if (row < rend) {
#pragma unroll
        for (int i = 0; i < 4; ++i) vnx[i] = ld_h4<HBF>(h, (size_t)row * 1024 + i * 256 + F.lane * 4); } }
    for (int row = rbeg; row < rend; row += rstep) {
        f32x4 v[4]; float ss = 0.f;
#pragma unroll
        for (int i = 0; i < 4; ++i) v[i] = vnx[i];
        { const int nrow = row + rstep; if (nrow < rend) {
#pragma unroll
            for (int i = 0; i < 4; ++i) vnx[i] = ld_h4<HBF>(h, (size_t)nrow * 1024 + i * 256 + F.lane * 4); } }
#pragma unroll
        for (int i = 0; i < 4; ++i) ss += v[i][0] * v[i][0] + v[i][1] * v[i][1] + v[i][2] * v[i][2] + v[i][3] * v[i][3];
        ss = wave_sum(ss); const float r = rsqrtf(ss * (1.0f / 1024.0f) + 1e-6f);
#pragma unroll
        for (int i = 0; i < 4; ++i) { v[i] = v[i] * r * gv[i]; u32x2 w; w.x = cvt_pk_bf16(v[i][0], v[i][1]); w.y = cvt_pk_bf16(v[i][2], v[i][3]); *(u32x2*)(dst + (size_t)row * 1024 + i * 256 + F.lane * 4) = w; }
        if (ROUTER) {
            f32x2 lgp[4];
#pragma unroll
            for (int e = 0; e < 4; ++e) lgp[e] = (f32x2){0.f, 0.f};
#pragma unroll
            for (int i = 0; i < 4; ++i)
#pragma unroll
                for (int j = 0; j < 4; ++j) { const LAS float* wp = wl + (((i * 4 + j) * 2) * 64 + F.lane) * 4; const f32x4 w0 = *(const LAS f32x4*)(wp), w1 = *(const LAS f32x4*)(wp + 256); const f32x2 f = {v[i][j], v[i][j]};
                    lgp[0] += f * (f32x2){w0[0], w0[1]}; lgp[1] += f * (f32x2){w0[2], w0[3]}; lgp[2] += f * (f32x2){w1[0], w1[1]}; lgp[3] += f * (f32x2){w1[2], w1[3]}; }
            float lg[8];
#pragma unroll
            for (int e = 0; e < 8; ++e) lg[e] = wave_sum(lgp[e >> 1][e & 1]) + brt[e];
            if (F.lane == 0) {
                int e0 = 0; float b0 = lg[0];
#pragma unroll
                for (int e = 1; e < 8; ++e) if (lg[e] > b0) { b0 = lg[e]; e0 = e; }
                int e1 = -1; float b1 = -3.0e38f;
#pragma unroll
                for (int e = 0; e < 8; ++e) if (e != e0 && lg[e] > b1) { b1 = lg[e]; e1 = e; }
                const float g0 = 1.0f / (1.0f + __expf(b1 - b0)), g1 = 1.0f - g0;
                const int p0 = __hip_atomic_fetch_add(&lcnt[e0], 1, __ATOMIC_RELAXED, __HIP_MEMORY_SCOPE_WORKGROUP), p1 = __hip_atomic_fetch_add(&lcnt[e1], 1, __ATOMIC_RELAXED, __HIP_MEMORY_SCOPE_WORKGROUP);
                tok_e[row * 2] = e0; tok_e[row * 2 + 1] = e1; tok_p[row * 2] = p0; tok_p[row * 2 + 1] = p1; tok_g[row * 2] = g0; tok_g[row * 2 + 1] = g1;
            }
        }
    }
    if (ROUTER) { __syncthreads(); if (F.tid < 8) cnt[F.bid * 8 + F.tid] = lcnt[F.tid]; }
}

__device__ __forceinline__ void phase_final_norm(const Ctx& F, float* h, const float* g) {
    f32x4 gv[4];
#pragma unroll
    for (int i = 0; i < 4; ++i) gv[i] = *(const f32x4*)(g + i * 256 + F.lane * 4);
    for (int row = F.bid * NWAVES + F.wave; row < T_; row += F.G * NWAVES) {
        float* hr = h + (size_t)row * 1024; f32x4 v[4]; float ss = 0.f;
#pragma unroll
        for (int i = 0; i < 4; ++i) { v[i] = *(const f32x4*)(hr + i * 256 + F.lane * 4); ss += v[i][0] * v[i][0] + v[i][1] * v[i][1] + v[i][2] * v[i][2] + v[i][3] * v[i][3]; }
        ss = wave_sum(ss); const float r = rsqrtf(ss * (1.0f / 1024.0f) + 1e-6f);
#pragma unroll
        for (int i = 0; i < 4; ++i) *(f32x4*)(hr + i * 256 + F.lane * 4) = v[i] * r * gv[i];
    }
}

__device__ __forceinline__ void phase_pool(const Ctx& F, const bf16_t* U, bf16_t* OP) {
    for (int idx = F.bid * NTHR + F.tid; idx < T_; idx += F.G * NTHR) {
        const int seg = idx >> 6, c8 = (idx & 63) * 8, grp = c8 >> 7, w = 2 << grp, t0 = seg * 64, tt0 = t0 & (S_ - 1);
        const bf16_t* up = U + (size_t)t0 * 512 + c8; bf16_t* op = OP + (size_t)t0 * 1024 + 512 + c8;
        f32x4 s0 = (f32x4){0.f, 0.f, 0.f, 0.f}, s1 = s0;
        if (tt0 > 0) { u32x4 pv[16];
#pragma unroll
            for (int i = 1; i <= 16; ++i) { const int off = ((i <= w) ? i : 1) * 512; pv[i - 1] = *(const u32x4*)(up - off); }
#pragma unroll
            for (int i = 1; i <= 16; ++i) if (i <= w) { f32x4 a, b; pg8::unpack8(pv[i - 1], a, b); s0 += a; s1 += b; } }
#pragma unroll 1
        for (int tb = 0; tb < 64; tb += 8) { u32x4 nv[8], ov[8];
#pragma unroll
            for (int j = 0; j < 8; ++j) { const int t = tb + j; nv[j] = *(const u32x4*)(up + (size_t)t * 512); const int tt = tt0 + t; const int oo = ((tt >= w) ? t - w : t) * 512; ov[j] = *(const u32x4*)(up + oo); }
#pragma unroll
            for (int j = 0; j < 8; ++j) { const int t = tb + j, tt = tt0 + t; f32x4 a, b; pg8::unpack8(nv[j], a, b); s0 += a; s1 += b;
                if (tt >= w) { f32x4 oa, ob; pg8::unpack8(ov[j], oa, ob); s0 -= oa; s1 -= ob; }
                const float inv = 1.0f / (float)((tt + 1 < w) ? tt + 1 : w);
                *(u32x4*)(op + (size_t)t * 1024) = pg8::pack8(s0 * inv - a, s1 * inv - b); } }
    }
}

__device__ __forceinline__ void phase_cmp2(const Ctx& F, const bf16_t* HC, const float* w2  , bf16_t* KC, int blk0, int blk1, int bstep) {
    LAS float* wl = (LAS float*)F.lds;
    LAS float* hl = (LAS float*)(F.lds + 65536) + F.wave * 2048;
    int kv_loaded = -1;
    for (int blk = blk0; blk < blk1; blk += bstep) {
        const int kv = blk >> 7;
        if (kv != kv_loaded) { __syncthreads(); for (int i = F.tid; i < 256 * 64 / 4; i += NTHR) *(LAS f32x4*)(wl + i * 4) = *(const f32x4*)(w2 + (size_t)kv * 256 * 64 + i * 4); kv_loaded = kv; __syncthreads(); }
        const int row0 = blk * 64 + F.wave * 8;
        LDS_FENCE();
#pragma unroll
        for (int r = 0; r < 8; ++r) { const u32x2 wv = *(const u32x2*)(HC + (size_t)(row0 + r) * 256 + F.lane * 4);
            hl[(F.lane * 4 + 0) * 8 + r] = __uint_as_float(wv.x << 16); hl[(F.lane * 4 + 1) * 8 + r] = __uint_as_float(wv.x & 0xffff0000u);
            hl[(F.lane * 4 + 2) * 8 + r] = __uint_as_float(wv.y << 16); hl[(F.lane * 4 + 3) * 8 + r] = __uint_as_float(wv.y & 0xffff0000u); }
        LDS_FENCE();
        float acc[8];
#pragma unroll
        for (int r = 0; r < 8; ++r) acc[r] = 0.f;
#pragma unroll 4
        for (int c = 0; c < 256; ++c) { const float w = wl[c * 64 + F.lane]; const f32x4 h0 = *(const LAS f32x4*)(hl + c * 8), h1 = *(const LAS f32x4*)(hl + c * 8 + 4);
            acc[0] += h0[0] * w; acc[1] += h0[1] * w; acc[2] += h0[2] * w; acc[3] += h0[3] * w; acc[4] += h1[0] * w; acc[5] += h1[1] * w; acc[6] += h1[2] * w; acc[7] += h1[3] * w; }
#pragma unroll
        for (int r = 0; r < 8; ++r) KC[(size_t)(row0 + r) * 64 + F.lane] = f2bf(acc[r]);
    }
}

__device__ __forceinline__ void dot4_row(const bf16_t* krow, const LAS float* qf, float (&s)[4]) {
    s[0] = s[1] = s[2] = s[3] = 0.f;
    u32x4 kr[8];
#pragma unroll
    for (int c = 0; c < 8; ++c) kr[c] = *(const u32x4*)(krow + c * 8);
#pragma unroll
    for (int c = 0; c < 8; ++c) { const u32x4 wv = kr[c]; f32x4 a, b; pg8::unpack8(wv, a, b); asm volatile("" ::: "memory");
#pragma unroll
        for (int i = 0; i < 4; ++i) { const f32x4 q0 = *(const LAS f32x4*)(qf + (c * 8 + i) * 4), q1 = *(const LAS f32x4*)(qf + (c * 8 + 4 + i) * 4);
            s[0] += a[i] * q0[0]; s[1] += a[i] * q0[1]; s[2] += a[i] * q0[2]; s[3] += a[i] * q0[3];
            s[0] += b[i] * q1[0]; s[1] += b[i] * q1[1]; s[2] += b[i] * q1[2]; s[3] += b[i] * q1[3]; } }
}
__device__ __forceinline__ void softmax4(LAS float* sc, int nkeys, int lane) {
    float m[4] = {-3.0e38f, -3.0e38f, -3.0e38f, -3.0e38f};
    for (int n = lane; n < nkeys; n += 64) { const f32x4 v = *(const LAS f32x4*)(sc + n * 4); m[0] = fmaxf(m[0], v[0]); m[1] = fmaxf(m[1], v[1]); m[2] = fmaxf(m[2], v[2]); m[3] = fmaxf(m[3], v[3]); }
#pragma unroll
    for (int h = 0; h < 4; ++h) m[h] = wave_max(m[h]);
    float l[4] = {0.f, 0.f, 0.f, 0.f};
    for (int n = lane; n < nkeys; n += 64) { f32x4 v = *(const LAS f32x4*)(sc + n * 4);
#pragma unroll
        for (int h = 0; h < 4; ++h) { v[h] = __expf(v[h] - m[h]); l[h] += v[h]; }
        *(LAS f32x4*)(sc + n * 4) = v; }
#pragma unroll
    for (int h = 0; h < 4; ++h) l[h] = 1.0f / wave_sum(l[h]);
    for (int n = lane; n < nkeys; n += 64) { f32x4 v = *(const LAS f32x4*)(sc + n * 4); v[0] *= l[0]; v[1] *= l[1]; v[2] *= l[2]; v[3] *= l[3]; *(LAS f32x4*)(sc + n * 4) = v; }
    LDS_FENCE();
}

__device__ __forceinline__ void phase_attn_naive(const Ctx& F, const bf16_t* Q, const bf16_t* KV, const bf16_t* KC, const float* GT, bf16_t* OP) {
    LAS float* qf = (LAS float*)(F.lds + F.wave * 16384);
    LAS float* sc = qf + 256;
    const int lane = F.lane;
    for (int unit = F.bid * NWAVES + F.wave; unit < T_ * 2; unit += F.G * NWAVES) {
        const int tt = unit & (S_ - 1), bg = unit >> 11, g = bg & 1, b = bg >> 1; const size_t t = (size_t)b * S_ + tt;
        LDS_FENCE();
#pragma unroll
        for (int h = 0; h < 4; ++h) qf[lane * 4 + h] = bf2f(Q[t * 512 + (g * 4 + h) * 64 + lane]);
        LDS_FENCE();
        const bf16_t* kc = KC + ((size_t)(0 * 2 + g) * 4096 + b * 128) * 64; const bf16_t* vc = KC + ((size_t)(1 * 2 + g) * 4096 + b * 128) * 64;
        const bf16_t* ks = KV + ((size_t)(2 * 2 + g) * T_ + (size_t)b * S_) * 64; const bf16_t* vs = KV + ((size_t)(3 * 2 + g) * T_ + (size_t)b * S_) * 64;
        const bf16_t* kw = KV + ((size_t)(4 * 2 + g) * T_ + (size_t)b * S_) * 64; const bf16_t* vw = KV + ((size_t)(5 * 2 + g) * T_ + (size_t)b * S_) * 64;
        int ncv = (tt >= 31) ? ((tt - 31) >> 4) + 1 : 0; if (ncv > 127) ncv = 127;
        float ocmp[4] = {0.f, 0.f, 0.f, 0.f}; float imp = 0.f;
        if (ncv > 0) {
#pragma unroll 1
            for (int n0 = 0; n0 < 128; n0 += 64) { const int n = n0 + lane; float s[4]; dot4_row(kc + (size_t)(n < 127 ? n : 126) * 64, qf, s);
                f32x4 v; const bool ok = n < ncv; v[0] = ok ? s[0] : -INFINITY; v[1] = ok ? s[1] : -INFINITY; v[2] = ok ? s[2] : -INFINITY; v[3] = ok ? s[3] : -INFINITY; *(LAS f32x4*)(sc + n * 4) = v; }
            LDS_FENCE();
            softmax4(sc, 128, lane);
            if (lane < 32) { const int nlo = (4 * lane - 1 < 0) ? 0 : 4 * lane - 1, nhi = (4 * lane + 3 > 126) ? 126 : 4 * lane + 3;
                for (int n = nlo; n <= nhi; ++n) { const f32x4 v = *(const LAS f32x4*)(sc + n * 4); imp += (v[0] + v[1]) + (v[2] + v[3]); } }
#pragma unroll 4
            for (int n = 0; n < ncv; ++n) { const f32x4 pv = *(const LAS f32x4*)(sc + n * 4); const float v = bf2f(vc[(size_t)n * 64 + lane]);
                ocmp[0] += pv[0] * v; ocmp[1] += pv[1] * v; ocmp[2] += pv[2] * v; ocmp[3] += pv[3] * v; }
        }
        const int cur = tt >> 6; unsigned selmask = 0u;
        { float val = -3.0e38f; if (lane < 32) { val = imp; if (lane > cur) val = -1.0e9f; if (lane == 0 || lane == cur) val = 1.0e9f; }
          for (int it = 0; it < 8; ++it) { float bv = val; int bi = lane;
#pragma unroll
              for (int o = 32; o >= 1; o >>= 1) { const float ov = __shfl_xor(bv, o); const int oi = __shfl_xor(bi, o); if (ov > bv || (ov == bv && oi < bi)) { bv = ov; bi = oi; } }
              selmask |= 1u << (bi & 31); if (lane == bi) val = -INFINITY; } }
        float osel[4] = {0.f, 0.f, 0.f, 0.f};
        { LDS_FENCE(); unsigned mk = selmask;
#pragma unroll 1
          for (int k = 0; k < 8; ++k) { const int j = __builtin_ctz(mk); mk &= mk - 1u; const int kpos = 64 * j + lane; float s[4]; dot4_row(ks + (size_t)kpos * 64, qf, s);
              const bool ok = kpos <= tt; f32x4 v; v[0] = ok ? s[0] : -INFINITY; v[1] = ok ? s[1] : -INFINITY; v[2] = ok ? s[2] : -INFINITY; v[3] = ok ? s[3] : -INFINITY; *(LAS f32x4*)(sc + (k * 64 + lane) * 4) = v; }
          LDS_FENCE();
          softmax4(sc, 512, lane);
          mk = selmask;
#pragma unroll 1
          for (int k = 0; k < 8; ++k) { const int j = __builtin_ctz(mk); mk &= mk - 1u; if (j > cur) continue; const bf16_t* vb = vs + (size_t)j * 64 * 64;
#pragma unroll 4
              for (int i = 0; i < 64; ++i) { const f32x4 pv = *(const LAS f32x4*)(sc + (k * 64 + i) * 4); const float v = bf2f(vb[(size_t)i * 64 + lane]);
                  osel[0] += pv[0] * v; osel[1] += pv[1] * v; osel[2] += pv[2] * v; osel[3] += pv[3] * v; } } }
        float owin[4] = {0.f, 0.f, 0.f, 0.f};
        { LDS_FENCE();
#pragma unroll 1
          for (int k = 0; k < 8; ++k) { const int kpos = tt - 511 + 64 * k + lane; const bool ok = kpos >= 0; float s[4]; dot4_row(kw + (size_t)(ok ? kpos : 0) * 64, qf, s);
              f32x4 v; v[0] = ok ? s[0] : -INFINITY; v[1] = ok ? s[1] : -INFINITY; v[2] = ok ? s[2] : -INFINITY; v[3] = ok ? s[3] : -INFINITY; *(LAS f32x4*)(sc + (k * 64 + lane) * 4) = v; }
          LDS_FENCE();
          softmax4(sc, 512, lane);
          const int k0 = (tt >= 511) ? 0 : 511 - tt;
#pragma unroll 4
          for (int i = k0; i < 512; ++i) { const f32x4 pv = *(const LAS f32x4*)(sc + i * 4); const float v = bf2f(vw[(size_t)(tt - 511 + i) * 64 + lane]);
              owin[0] += pv[0] * v; owin[1] += pv[1] * v; owin[2] += pv[2] * v; owin[3] += pv[3] * v; } }
        const float* gt = GT + t * 32 + g * 12;
#pragma unroll
        for (int h = 0; h < 4; ++h) { const float o = gt[h * 3] * ocmp[h] + gt[h * 3 + 1] * osel[h] + gt[h * 3 + 2] * owin[h]; OP[t * 1024 + (g * 4 + h) * 64 + lane] = f2bf(o); }
    }
}

namespace att {
typedef float f32x16 __attribute__((ext_vector_type(16)));
typedef short s16x4 __attribute__((ext_vector_type(4)));
constexpr float C2 = 1.4426950408889634f, NEG = -1.0e30f, THR = 8.0f;
constexpr int KSTR = 128;
__device__ __forceinline__ int koff(int row, int ch) { return row * 128 + ((ch ^ ((row >> 1) & 7)) << 4); }
constexpr int L_KB0 = 0, L_KB1 = 9216, L_VB0 = 18432, L_VB1 = 26624, L_WSF = 34816, L_SELM = 36864, L_GT = 37888, L_IMPA = 40960, L_IMPB = L_IMPA + 4 * 64 * 33 * 4, L_STG = L_IMPA, L_KB2 = L_IMPB + 4 * 64 * 33 * 4, L_VB2 = L_KB2 + 9216;
#define MFMA32(a, b, c) __builtin_amdgcn_mfma_f32_32x32x16_bf16(a, b, c, 0, 0, 0)
__device__ __forceinline__ int crow(int r, int hi) { return (r & 3) + 8 * (r >> 2) + 4 * hi; }
__device__ __forceinline__ s16x4 vtr(const LAS char* p) { return __builtin_bit_cast(s16x4, __builtin_amdgcn_ds_read_tr16_b64_v4i16((LAS s16x4*)p)); }
__device__ __forceinline__ float halfswap_sum(float x) { auto rr = __builtin_amdgcn_permlane32_swap(__float_as_uint(x), __float_as_uint(x), false, false); return __uint_as_float(rr[0]) + __uint_as_float(rr[1]); }
__device__ __forceinline__ float halfswap_max(float x) { auto rr = __builtin_amdgcn_permlane32_swap(__float_as_uint(x), __float_as_uint(x), false, false); return fmaxf(__uint_as_float(rr[0]), __uint_as_float(rr[1])); }
__device__ __forceinline__ float max3f(float a, float b, float c) { float d; asm("v_max3_f32 %0, %1, %2, %3" : "=v"(d) : "v"(a), "v"(b), "v"(c)); return d; }
__device__ __forceinline__ float rowmax32(const f32x16& p0, const f32x16& p1) {
    float a = max3f(p0[0], p1[0], p0[1]), b = max3f(p1[1], p0[2], p1[2]);
#pragma unroll
    for (int r = 3; r < 15; r += 2) { a = max3f(a, p0[r], p1[r]); b = max3f(b, p0[r + 1], p1[r + 1]); }
    a = max3f(a, p0[15], p1[15]);
    return halfswap_max(max3f(a, b, b)); }
__device__ __forceinline__ void mask_tile(f32x16& p0, f32x16& p1, int hi, int thr_hi, int thr_lo) {
#pragma unroll
    for (int r = 0; r < 16; ++r) { const int kk = crow(r, hi); if (kk > thr_hi || kk <= thr_lo) p0[r] = NEG; if (kk + 32 > thr_hi || kk + 32 <= thr_lo) p1[r] = NEG; } }
__device__ __forceinline__ void qk_tile(const LAS char* kb, const bf16x8 (&qr)[4], f32x16& p0, f32x16& p1, int r32, int hi) {
    bf16x8 kf[8];
#pragma unroll
    for (int d0 = 0; d0 < 4; ++d0)
#pragma unroll
        for (int n = 0; n < 2; ++n) kf[2 * d0 + n] = *(const LAS bf16x8*)(kb + koff(r32 + 32 * n, 2 * d0 + hi));
    f32x16 z = {};
    p0 = MFMA32(kf[0], qr[0], z); p1 = MFMA32(kf[1], qr[0], z);
#pragma unroll
    for (int d0 = 1; d0 < 4; ++d0) { p0 = MFMA32(kf[2 * d0], qr[d0], p0); p1 = MFMA32(kf[2 * d0 + 1], qr[d0], p1); }
}
__device__ __forceinline__ void pack_p(const f32x16& p0, const f32x16& p1, bf16x8 (&pa)[4]) {
#pragma unroll
    for (int k = 0; k < 2; ++k) { u32x4 w; w.x = cvt_pk_bf16(p0[8 * k], p0[8 * k + 1]); w.y = cvt_pk_bf16(p0[8 * k + 2], p0[8 * k + 3]); w.z = cvt_pk_bf16(p0[8 * k + 4], p0[8 * k + 5]); w.w = cvt_pk_bf16(p0[8 * k + 6], p0[8 * k + 7]); pa[k] = __builtin_bit_cast(bf16x8, w);
        u32x4 v; v.x = cvt_pk_bf16(p1[8 * k], p1[8 * k + 1]); v.y = cvt_pk_bf16(p1[8 * k + 2], p1[8 * k + 3]); v.z = cvt_pk_bf16(p1[8 * k + 4], p1[8 * k + 5]); v.w = cvt_pk_bf16(p1[8 * k + 6], p1[8 * k + 7]); pa[2 + k] = __builtin_bit_cast(bf16x8, v); }
}
__device__ __forceinline__ void pv_pa(const LAS char* vb, const bf16x8 (&pa)[4], f32x16 (&o)[2], int lane, int hi) {
    const LAS char* vp = vb + ((lane >> 4) & 1) * 32 + (lane & 3) * 8 + (4 * hi + ((lane & 15) >> 2)) * 64;
#pragma unroll
    for (int k = 0; k < 4; ++k)
#pragma unroll
        for (int d0 = 0; d0 < 2; ++d0) { const s16x4 lo = vtr(vp + d0 * 4096 + k * 1024), hh = vtr(vp + d0 * 4096 + k * 1024 + 512);
            const bf16x8 vf = (bf16x8){lo[0], lo[1], lo[2], lo[3], hh[0], hh[1], hh[2], hh[3]};
            o[d0] = MFMA32(pa[k], vf, o[d0]); }
}
__device__ __forceinline__ void pv_tile(const LAS char* vb, const f32x16& p0, const f32x16& p1, f32x16 (&o)[2], int lane, int hi) { bf16x8 pa[4]; pack_p(p0, p1, pa); pv_pa(vb, pa, o, lane, hi); }
struct St { f32x16 o[2]; float mhat, l; };
__device__ __forceinline__ void softmax_step(f32x16& p0, f32x16& p1, St& st, bool first, bool rowok, LAS float* wsf, int r32, int hi) {
    float rm = rowmax32(p0, p1); rm = rowok ? rm : -3.0e38f; bool resc = false;
    if (first) st.mhat = rm;
    else { const float gr = rm - st.mhat; if (__any(gr > THR)) { const float dl = fmaxf(gr, 0.f); st.mhat += dl; const float f = __builtin_amdgcn_exp2f(-dl); st.l *= f; if (hi == 0) wsf[r32] = f; resc = true; } }
    const float nmh = rowok ? -st.mhat : -INFINITY; float sa = 0.f, sb = 0.f;
#pragma unroll
    for (int r = 0; r < 16; ++r) { p0[r] = __builtin_amdgcn_exp2f(p0[r] + nmh); p1[r] = __builtin_amdgcn_exp2f(p1[r] + nmh); sa += p0[r]; sb += p1[r]; }
    st.l += sa + sb;
    if (resc) { LDS_FENCE();
#pragma unroll
        for (int r = 0; r < 16; ++r) { const float f = wsf[crow(r, hi)]; st.o[0][r] *= f; st.o[1][r] *= f; } }
}
__device__ __forceinline__ void finish_pass(const St& st, unsigned (&omix)[16], bool firstpass, LAS float* wsf, const LAS float* gtl, int gidx, int ph, int r32, int hi, bool rowvalid) {
    const float lt = halfswap_sum(st.l); const float inv = rowvalid ? 1.0f / lt : 0.f;
    LDS_FENCE(); if (hi == 0) wsf[32 + r32] = inv; LDS_FENCE();
#pragma unroll
    for (int r = 0; r < 16; ++r) { const int q = crow(r, hi); const float s = wsf[32 + q] * gtl[(32 * ph + q) * 12 + gidx];
        float a = st.o[0][r] * s, b = st.o[1][r] * s;
        if (!firstpass) { a += __uint_as_float(omix[r] << 16); b += __uint_as_float(omix[r] & 0xffff0000u); }
        omix[r] = cvt_pk_bf16(a, b); }
}
__device__ __forceinline__ void tile_to_lds(LAS char* kb, LAS char* vb, int tid, const u32x4 kr, const u32x4 vr) {
    const int key = tid >> 3, ch = tid & 7;
    *(LAS u32x4*)(kb + koff(key, ch)) = kr; *(LAS u32x4*)(vb + (ch >> 2) * 4096 + key * 64 + (ch & 3) * 16) = vr; }
__device__ __forceinline__ void dma_tile(LAS char* kb, LAS char* vb, const bf16_t* ksrc, const bf16_t* vsrc, int tid, int wave) {
    { const int row = tid >> 3, ch = (tid & 7) ^ ((row >> 1) & 7); __builtin_amdgcn_global_load_lds((const unsigned*)(ksrc + row * 64 + ch * 8), (LAS unsigned*)(kb + wave * 1024), 16, 0, 0); }
    { const int dh = tid >> 8, row = (tid >> 2) & 63, q = tid & 3; __builtin_amdgcn_global_load_lds((const unsigned*)(vsrc + row * 64 + (dh * 4 + q) * 8), (LAS unsigned*)(vb + wave * 1024), 16, 0, 0); }
}
}

__device__ __forceinline__ void phase_attn(const Ctx& F, const bf16_t* Q, const bf16_t* KV, const bf16_t* KC, const float* GT, bf16_t* OP) {
    using namespace att;
    LAS char* L = (LAS char*)F.lds; const int wave = F.wave, head = wave & 3, ph = wave >> 2;
    LAS float* wsf = (LAS float*)(L + L_WSF) + wave * 64; LAS unsigned* selm = (LAS unsigned*)(L + L_SELM); LAS float* gtl = (LAS float*)(L + L_GT);
    LAS float* impa = (LAS float*)(L + L_IMPA); LAS float* impb = (LAS float*)(L + L_IMPB);
    LAS char* kbuf[2] = {L + L_KB0, L + L_KB1}; LAS char* vbuf[2] = {L + L_VB0, L + L_VB1};
    for (int it = F.bid; it < 1024; it += F.G) {
        const int wq = it & 255, kq = it >> 8, bg = (wq & 7) + 8 * (wq >> 5), pr = ((wq >> 3) & 3) * 4 + kq, b = bg >> 1, g = bg & 1;
#pragma unroll 1
        for (int half = 0; half < 2; ++half) {
            int tid = F.tid; asm volatile("" : "+v"(tid)); const int lane = tid & 63, r32 = lane & 31, hi = lane >> 5, posl = 32 * ph + r32;
            const int c = half ? 31 - pr : pr; const size_t t0 = (size_t)b * S_ + 64 * c; const int tt = 64 * c + posl;
            bf16x8 qr[4];
#pragma unroll
            for (int d0 = 0; d0 < 4; ++d0) qr[d0] = *(const bf16x8*)(Q + (t0 + posl) * 512 + (g * 4 + head) * 64 + d0 * 16 + hi * 8);
            for (int i = tid; i < 768; i += NTHR) gtl[i] = GT[(t0 + i / 12) * 32 + g * 12 + (i % 12)];
            dma_tile(L + L_KB2, L + L_VB2, KV + ((size_t)(2 * 2 + g) * T_ + (size_t)b * S_) * 64, KV + ((size_t)(3 * 2 + g) * T_ + (size_t)b * S_) * 64, tid, wave);
            unsigned omix[16]; int pass_slot = 2;
            { const bf16_t* kc = KC + ((size_t)(0 * 2 + g) * 4096 + b * 128) * 64; const bf16_t* vc = KC + ((size_t)(1 * 2 + g) * 4096 + b * 128) * 64;
              const u32x4 k0 = *(const u32x4*)(kc + tid * 8), v0 = *(const u32x4*)(vc + tid * 8), k1 = *(const u32x4*)(kc + 4096 + tid * 8), v1 = *(const u32x4*)(vc + 4096 + tid * 8);
              tile_to_lds(kbuf[0], vbuf[0], tid, k0, v0); tile_to_lds(kbuf[1], vbuf[1], tid, k1, v1);
              __syncthreads();
              const int nv = (tt >= 31) ? ((tt - 31) >> 4) : -1; const bool rowvalid = nv >= 0;
              const bool two = c >= 16;
              f32x16 a0, a1, b0, b1; qk_tile(kbuf[0], qr, a0, a1, r32, hi); if (two) qk_tile(kbuf[1], qr, b0, b1, r32, hi); else { b0 = f32x16{}; b1 = f32x16{}; }
              mask_tile(a0, a1, hi, rowvalid ? nv : 1000, -1); mask_tile(b0, b1, hi, (rowvalid || !two) ? nv - 64 : 1000, -1);
              St st; st.o[0] = f32x16{}; st.o[1] = f32x16{};
              st.mhat = fmaxf(rowmax32(a0, a1), rowmax32(b0, b1)); const float nmh = -st.mhat; float sacc = 0.f;
#pragma unroll
              for (int r = 0; r < 16; ++r) { a0[r] = __builtin_amdgcn_exp2f(a0[r] + nmh); a1[r] = __builtin_amdgcn_exp2f(a1[r] + nmh);
                  b0[r] = __builtin_amdgcn_exp2f(b0[r] + nmh); b1[r] = __builtin_amdgcn_exp2f(b1[r] + nmh); sacc += (a0[r] + a1[r]) + (b0[r] + b1[r]); }
              st.l = sacc;
              if (c >= 8) {
                  const float inv = rowvalid ? 1.0f / halfswap_sum(sacc) : 0.f; LAS float* ia = impa + (head * 64 + posl) * 33; LAS float* ib = impb + (head * 64 + posl) * 33;
#pragma unroll
                  for (int rr = 0; rr < 4; ++rr) {
                      { const int jb = 0 + 2 * rr + hi; ia[jb] = ((a0[4 * rr] + a0[4 * rr + 1]) + (a0[4 * rr + 2] + a0[4 * rr + 3])) * inv; ib[jb + 1] = a0[4 * rr + 3] * inv; }
                      { const int jb = 8 + 2 * rr + hi; ia[jb] = ((a1[4 * rr] + a1[4 * rr + 1]) + (a1[4 * rr + 2] + a1[4 * rr + 3])) * inv; ib[jb + 1] = a1[4 * rr + 3] * inv; }
                      { const int jb = 16 + 2 * rr + hi; ia[jb] = ((b0[4 * rr] + b0[4 * rr + 1]) + (b0[4 * rr + 2] + b0[4 * rr + 3])) * inv; ib[jb + 1] = b0[4 * rr + 3] * inv; }
                      { const int jb = 24 + 2 * rr + hi; ia[jb] = ((b1[4 * rr] + b1[4 * rr + 1]) + (b1[4 * rr + 2] + b1[4 * rr + 3])) * inv; if (jb + 1 < 32) ib[jb + 1] = b1[4 * rr + 3] * inv; }
                  }
              }
              pv_tile(vbuf[0], a0, a1, st.o, lane, hi); if (two) pv_tile(vbuf[1], b0, b1, st.o, lane, hi);
              finish_pass(st, omix, true, wsf, gtl, head * 3 + 0, ph, r32, hi, rowvalid);
            }
            __syncthreads();
            if (c >= 8) {
                LAS float* impf = (LAS float*)(L + L_KB0);
                { const int p = tid >> 3, j0 = (tid & 7) * 4; f32x4 v;
#pragma unroll
                  for (int jj = 0; jj < 4; ++jj) { const int j = j0 + jj; float val = 0.f;
#pragma unroll
                      for (int h = 0; h < 4; ++h) val += impa[(h * 64 + p) * 33 + j];
                      if (j > 0) {
#pragma unroll
                          for (int h = 0; h < 4; ++h) val += impb[(h * 64 + p) * 33 + j]; }
                      if (j > c) val = -1.0e9f; if (j == 0 || j == c) val = 1.0e9f; v[jj] = val; }
                  *(LAS f32x4*)(impf + p * 32 + j0) = v; }
                __syncthreads();
#pragma unroll 1
                for (int i2 = 0; i2 < 4; ++i2) { const int p = wave * 8 + 2 * i2 + hi, j = r32; const float my = impf[p * 32 + j]; int rank = 0;
#pragma unroll
                    for (int q = 0; q < 8; ++q) { const f32x4 v = *(const LAS f32x4*)(impf + p * 32 + q * 4);
#pragma unroll
                        for (int e = 0; e < 4; ++e) { const int i = q * 4 + e; rank += (v[e] > my || (v[e] == my && i < j)) ? 1 : 0; } }
                    const unsigned long long bal = __builtin_amdgcn_ballot_w64(rank < 8);
                    if (j == 0) selm[p] = hi ? (unsigned)(bal >> 32) : (unsigned)bal; }
            } else if (tid < 64) selm[tid] = (2u << c) - 1u;
            __syncthreads();
            const unsigned mysel = selm[posl]; unsigned uni = selm[lane];
#pragma unroll
            for (int o = 32; o >= 1; o >>= 1) uni |= __shfl_xor(uni, o);
            uni = __builtin_amdgcn_readfirstlane(uni) & ((c >= 31) ? 0xffffffffu : ((2u << c) - 1u));
#pragma unroll 1
            for (int pass = 0; pass < 2; ++pass) {
                const bf16_t* kb = KV + ((size_t)((2 + 2 * pass) * 2 + g) * T_ + (size_t)b * S_) * 64; const bf16_t* vb = KV + ((size_t)((3 + 2 * pass) * 2 + g) * T_ + (size_t)b * S_) * 64;
                unsigned um; if (pass == 0) um = uni; else { const int jl = (c >= 8) ? c - 8 : 0; um = ((c >= 31) ? 0xffffffffu : ((2u << c) - 1u)) & ~((1u << jl) - 1u); }
                int j = pass == 0 ? __builtin_ctz(um) : 31 - __builtin_clz(um); um &= ~(1u << j);
                f32x16 oo[2]; oo[0] = f32x16{}; oo[1] = f32x16{}; f32x16 ls = {}; float mhat = 0.f; int sb = pass_slot, sprev = 0; f32x16 pp0, pp1;
                u32x4 onesw = {0x3f803f80u, 0x3f803f80u, 0x3f803f80u, 0x3f803f80u}; asm volatile("" : "+v"(onesw)); const bf16x8 ones = __builtin_bit_cast(bf16x8, onesw);
                u32x4 qx = {0u, 0u, 0u, 0u}; asm volatile("" : "+v"(qx));
#define KSLOT(s) (L + ((s) == 0 ? L_KB0 : ((s) == 1 ? L_KB1 : L_KB2)))
#define VSLOT(s) (L + ((s) == 0 ? L_VB0 : ((s) == 1 ? L_VB1 : L_VB2)))
#define NEXT_TILE(jn) do { jn = -1; const int sn_ = (sb == 2) ? 0 : sb + 1; \
        if (um) { jn = pass == 0 ? __builtin_ctz(um) : 31 - __builtin_clz(um); um &= ~(1u << jn); dma_tile(KSLOT(sn_), VSLOT(sn_), kb + (size_t)jn * 4096, vb + (size_t)jn * 4096, tid, wave); } \
        else if (pass == 0) { dma_tile(KSLOT(sn_), VSLOT(sn_), KV + ((size_t)(4 * 2 + g) * T_ + (size_t)b * S_) * 64 + (size_t)c * 4096, KV + ((size_t)(5 * 2 + g) * T_ + (size_t)b * S_) * 64 + (size_t)c * 4096, tid, wave); pass_slot = sn_; } } while (0)
                bool more;
                {
                    int j1; NEXT_TILE(j1);
                    f32x16 p0, p1; qk_tile(KSLOT(sb), qr, p0, p1, r32, hi);
                    const bool rowok = (pass != 0) || (((mysel >> j) & 1u) != 0u);
                    if (j == c) mask_tile(p0, p1, hi, posl, -1); else if (pass == 1 && j == c - 8) mask_tile(p0, p1, hi, 1000, posl);
                    const float rm = rowmax32(p0, p1); mhat = __uint_as_float(cvt_pk_bf16(rm, rm) << 16); const float nmh = rowok ? -mhat : -INFINITY;
#pragma unroll
                    for (int r = 0; r < 16; ++r) { p0[r] = __builtin_amdgcn_exp2f(p0[r] + nmh); p1[r] = __builtin_amdgcn_exp2f(p1[r] + nmh); }
                    pp0 = p0; pp1 = p1; sprev = sb; more = j1 >= 0;
                    if (more) { __syncthreads(); sb = (sb == 2) ? 0 : sb + 1; j = j1; }
                }
                while (more) {
                    int j1; NEXT_TILE(j1);
                    const bool rowok = (pass != 0) || (((mysel >> j) & 1u) != 0u);
                    qx.x = hi ? 0u : (rowok ? (__float_as_uint(-mhat) >> 16) : 0xFF7Fu);
                    f32x16 p0, p1; u32x4 pw[4];
                    { const LAS char* kbp = KSLOT(sb); bf16x8 kf[8];
#pragma unroll
                      for (int d0 = 0; d0 < 2; ++d0) { kf[2 * d0] = *(const LAS bf16x8*)(kbp + koff(r32, 2 * d0 + hi)); kf[2 * d0 + 1] = *(const LAS bf16x8*)(kbp + koff(r32 + 32, 2 * d0 + hi)); }
                      f32x16 z = {}; p0 = MFMA32(ones, __builtin_bit_cast(bf16x8, qx), z); p1 = MFMA32(ones, __builtin_bit_cast(bf16x8, qx), z);
#pragma unroll
                      for (int i = 0; i < 8; ++i) { const int d0 = i >> 1;
                          if (i < 4) { const int n = i + 4; kf[n] = *(const LAS bf16x8*)(kbp + koff(r32 + 32 * (n & 1), 2 * (n >> 1) + hi)); }
                          if ((i & 1) == 0) p0 = MFMA32(kf[2 * d0], qr[d0], p0); else p1 = MFMA32(kf[2 * d0 + 1], qr[d0], p1);
#pragma unroll
                          for (int w = 2 * i; w < 2 * i + 2; ++w) { const int t = w >> 2, e = 2 * (w & 3); unsigned v;
                              if (t < 2) v = cvt_pk_bf16(pp0[8 * t + e], pp0[8 * t + e + 1]); else v = cvt_pk_bf16(pp1[8 * (t - 2) + e], pp1[8 * (t - 2) + e + 1]);
                              asm volatile("" : "+v"(v)); pw[t][w & 3] = v; }
                          __builtin_amdgcn_sched_barrier(0); }
                    }
                    if (j == c) mask_tile(p0, p1, hi, posl, -1); else if (pass == 1 && j == c - 8) mask_tile(p0, p1, hi, 1000, posl);
                    float gr = rowmax32(p0, p1); bool resc = false;
                    if (__any(gr > THR)) { const float dl = fmaxf(gr, 0.f); const float nm = __uint_as_float(cvt_pk_bf16(mhat + dl, mhat + dl) << 16); const float dq = nm - mhat; mhat = nm;
                        const float f = __builtin_amdgcn_exp2f(-dq); if (hi == 0) wsf[r32] = f; resc = true;
#pragma unroll
                        for (int r = 0; r < 16; ++r) { p0[r] -= dq; p1[r] -= dq; } }
                    asm volatile("" : "+v"(p0), "+v"(p1));
                    { const LAS char* vp = VSLOT(sprev) + ((lane >> 4) & 1) * 32 + (lane & 3) * 8 + (4 * hi + ((lane & 15) >> 2)) * 64;
#pragma unroll
                      for (int i = 0; i < 8; ++i) { const int k = i >> 1, d0 = i & 1;
                          const s16x4 lo = vtr(vp + d0 * 4096 + k * 1024), hh = vtr(vp + d0 * 4096 + k * 1024 + 512);
                          const bf16x8 vf = (bf16x8){lo[0], lo[1], lo[2], lo[3], hh[0], hh[1], hh[2], hh[3]};
                          oo[d0] = MFMA32(__builtin_bit_cast(bf16x8, pw[k]), vf, oo[d0]);
                          if (d0 == 1) ls = MFMA32(__builtin_bit_cast(bf16x8, pw[k]), ones, ls);
#pragma unroll
                          for (int r = 0; r < 4; ++r) { if (i < 4) p0[4 * i + r] = __builtin_amdgcn_exp2f(p0[4 * i + r]); else p1[4 * (i - 4) + r] = __builtin_amdgcn_exp2f(p1[4 * (i - 4) + r]); }
                          asm volatile("" : "+v"(p0), "+v"(p1));
                          __builtin_amdgcn_sched_barrier(0); }
                    }
                    if (resc) { LDS_FENCE();
#pragma unroll
                        for (int r = 0; r < 16; ++r) { const float f = wsf[crow(r, hi)]; oo[0][r] *= f; oo[1][r] *= f; ls[r] *= f; } }
                    pp0 = p0; pp1 = p1; sprev = sb; more = j1 >= 0;
                    if (more) { __syncthreads(); sb = (sb == 2) ? 0 : sb + 1; j = j1; }
                }
                { bf16x8 ppa[4]; pack_p(pp0, pp1, ppa);
                  pv_pa(VSLOT(sprev), ppa, oo, lane, hi);
#pragma unroll
                  for (int k = 0; k < 4; ++k) ls = MFMA32(ppa[k], ones, ls); }
#undef KSLOT
#undef VSLOT
#undef NEXT_TILE
#pragma unroll
                for (int r = 0; r < 16; ++r) { const int q = crow(r, hi); const float sc_ = __builtin_amdgcn_rcpf(ls[r]) * gtl[(32 * ph + q) * 12 + head * 3 + 1 + pass];
                    const float a = oo[0][r] * sc_ + __uint_as_float(omix[r] << 16), bq = oo[1][r] * sc_ + __uint_as_float(omix[r] & 0xffff0000u);
                    omix[r] = cvt_pk_bf16(a, bq); }
                __syncthreads();
            }
            { bf16_t* Ow = OP + (t0 + 32 * ph) * 1024 + (g * 4 + head) * 64; LAS bf16_t* stg = (LAS bf16_t*)(L + L_STG) + wave * 2048;
#pragma unroll
              for (int r = 0; r < 16; ++r) { const int orow = crow(r, hi);
#pragma unroll
                  for (int d0 = 0; d0 < 2; ++d0) stg[orow * 64 + d0 * 32 + r32] = (bf16_t)(d0 ? (omix[r] >> 16) : (omix[r] & 0xffffu)); }
              LDS_FENCE();
#pragma unroll
              for (int i = 0; i < 4; ++i) { const int row = i * 8 + (lane >> 3), ch = lane & 7; *(u32x4*)(Ow + (size_t)row * 1024 + ch * 8) = *(const LAS u32x4*)(stg + row * 64 + ch * 8); } }
            __syncthreads();
        }
    }
}

__device__ __forceinline__ int moe_tile_starts(const int* cnt, int (&ts)[NE_ + 1]) {
    int acc = 0;
#pragma unroll
    for (int e = 0; e < NE_; ++e) { ts[e] = acc; acc += (cnt[e] + 255) >> 8; }
    ts[NE_] = acc; return acc;
}
__device__ __forceinline__ void phase_moe_assign(const Ctx& F, const int* wgcnt, int* cnt, const int* tok_e, const int* tok_p, int* row_tok, int* row_dst) {
    LAS int* pre = (LAS int*)F.lds;
    for (int i = F.tid; i < F.G * 8; i += NTHR) pre[i] = wgcnt[i];
    __syncthreads();
    if (F.tid < 8) { int acc = 0; for (int w = 0; w < F.G; ++w) { const int v = pre[w * 8 + F.tid]; pre[w * 8 + F.tid] = acc; acc += v; } pre[F.G * 8 + F.tid] = acc; if (F.bid == 0) cnt[F.tid] = acc; }
    __syncthreads();
    int ts[NE_ + 1]; { int acc = 0;
#pragma unroll
        for (int e = 0; e < NE_; ++e) { ts[e] = acc; acc += (pre[F.G * 8 + e] + 255) >> 8; } ts[NE_] = acc; }
    for (int idx = F.bid * NTHR + F.tid; idx < T_ * 2; idx += F.G * NTHR) { const int e = tok_e[idx]; int st = 0;
#pragma unroll
        for (int k = 0; k < NE_; ++k) st = (k == e) ? ts[k] : st;
        const int r = idx >> 1, w = (T_ % (F.G * NWAVES) == 0) ? r / (T_ / F.G) : (r % (F.G * NWAVES)) / NWAVES;
        const int row = st * 256 + pre[w * 8 + e] + tok_p[idx]; row_tok[row] = r; row_dst[row] = idx; }
}
__device__ __forceinline__ void phase_moe_gather(const Ctx& F, const bf16_t* f, const int* row_tok, bf16_t* xs, int nrows) {
    for (int r = F.bid * NWAVES + F.wave; r < nrows; r += F.G * NWAVES) { const bf16_t* src = f + (size_t)row_tok[r] * 1024; bf16_t* dst = xs + (size_t)r * 1024;
        *(u32x4*)(dst + F.lane * 8) = *(const u32x4*)(src + F.lane * 8); *(u32x4*)(dst + 512 + F.lane * 8) = *(const u32x4*)(src + 512 + F.lane * 8); }
}
__device__ __forceinline__ void phase_moe_combine(const Ctx& F, bf16_t* h, float* outf, const bf16_t* yb, const float* tok_g, const float* g, bf16_t* dst) {
    f32x4 gv[4];
#pragma unroll
    for (int i = 0; i < 2; ++i) { gv[2 * i] = *(const f32x4*)(g + i * 512 + F.lane * 8); gv[2 * i + 1] = *(const f32x4*)(g + i * 512 + F.lane * 8 + 4); }
    u32x4 nh[2], ny0[2], ny1[2]; float ng0 = 0.f, ng1 = 0.f;
#define CMB_LOAD(row_) do { const int r_ = (row_); ng0 = tok_g[r_ * 2]; ng1 = tok_g[r_ * 2 + 1]; _Pragma("unroll") for (int i = 0; i < 2; ++i) { const int c = i * 512 + F.lane * 8; \
        nh[i] = *(const u32x4*)(h + (size_t)r_ * 1024 + c); ny0[i] = *(const u32x4*)(yb + (size_t)(r_ * 2) * 1024 + c); ny1[i] = *(const u32x4*)(yb + (size_t)(r_ * 2 + 1) * 1024 + c); } } while (0)
    { const int row = F.bid * NWAVES + F.wave; if (row < T_) CMB_LOAD(row); }
    for (int row = F.bid * NWAVES + F.wave; row < T_; row += F.G * NWAVES) { const float g0 = ng0, g1 = ng1; bf16_t* hr = h + (size_t)row * 1024; f32x4 v[4]; float ss = 0.f;
#pragma unroll
        for (int i = 0; i < 2; ++i) { f32x4 ha, hb, a0, b0, a1, b1; pg8::unpack8(nh[i], ha, hb); pg8::unpack8(ny0[i], a0, b0); pg8::unpack8(ny1[i], a1, b1);
            v[2 * i] = ha + a0 * g0 + a1 * g1; v[2 * i + 1] = hb + b0 * g0 + b1 * g1; }
#pragma unroll
        for (int i = 0; i < 4; ++i) ss += v[i][0] * v[i][0] + v[i][1] * v[i][1] + v[i][2] * v[i][2] + v[i][3] * v[i][3];
        { const int nrow = row + F.G * NWAVES; if (nrow < T_) CMB_LOAD(nrow); }
        ss = wave_sum(ss); const float r = rsqrtf(ss * (1.0f / 1024.0f) + 1e-6f);
        if (dst) {
#pragma unroll
            for (int i = 0; i < 2; ++i) { const int c = i * 512 + F.lane * 8; *(u32x4*)(hr + c) = pg8::pack8(v[2 * i], v[2 * i + 1]);
                *(u32x4*)(dst + (size_t)row * 1024 + c) = pg8::pack8(v[2 * i] * r * gv[2 * i], v[2 * i + 1] * r * gv[2 * i + 1]); }
        } else {
#pragma unroll
            for (int i = 0; i < 2; ++i) { const int c = i * 512 + F.lane * 8; *(f32x4*)(outf + (size_t)row * 1024 + c) = v[2 * i] * r * gv[2 * i]; *(f32x4*)(outf + (size_t)row * 1024 + c + 4) = v[2 * i + 1] * r * gv[2 * i + 1]; }
        }
    }
#undef CMB_LOAD
}

#define bufA ((bf16_t*)(ws + WS_BUFA))
#define Qb ((bf16_t*)(ws + R1_Q))
#define KVb ((bf16_t*)(ws + R1_KV))
#define Ub ((bf16_t*)(ws + R1_U))
#define GTb ((float*)(ws + R1_GT))
#define RATIOb ((bf16_t*)(ws + R1_RATIO))
#define S1b ((bf16_t*)(ws + R1_S1))
#define MERGEDb ((bf16_t*)(ws + R1_MERGED))
#define HCb ((bf16_t*)(ws + WS_HC))
#define KCb ((bf16_t*)(ws + WS_KC))
#define tok_e ((int*)(ws + WS_TOKE))
#define tok_p ((int*)(ws + WS_TOKP))
#define tok_g ((float*)(ws + WS_TOKG))
#define row_tok ((int*)(ws + WS_ROWT))
#define row_dst ((int*)(ws + WS_ROWD))
template <unsigned TMASK>
__global__ void __launch_bounds__(NTHR, 2) fwd(Params p0) {
    extern __shared__ __attribute__((aligned(16))) unsigned char lds_raw[];
    Ctx F; F.lds = (LAS unsigned char*)lds_raw; F.tid = threadIdx.x; F.lane = F.tid & 63; F.wave = __builtin_amdgcn_readfirstlane(F.tid >> 6); F.G = gridDim.x; F.bid = blockIdx.x;
    volatile LAS unsigned* MISC = (volatile LAS unsigned*)(F.lds + MISC_OFF);
    if (F.tid < 64) MISC[F.tid] = 0u;
    __syncthreads();
    XcdBarrier bar; bar.bar = (unsigned*)(p0.ws + WS_CTL); bar.x = 0; bar.st = nullptr;
    if (!MK_PER_PHASE) bar = xcd_barrier_post((unsigned*)(p0.ws + WS_CTL), MISC + 8);
    const int lo = p0.ph_lo, hi = p0.ph_hi; int ph = 0;
#define PH_BEGIN(k) if constexpr ((TMASK >> (k)) & 1u) if (ph >= lo && ph < hi) { Params p; load_params(p); unsigned char* ws = launder_ws(p.ws); asm volatile("v_mbcnt_lo_u32_b32 %0, -1, 0\n\tv_mbcnt_hi_u32_b32 %0, -1, %0" : "=v"(F.lane)); F.wave = __builtin_amdgcn_readfirstlane(F.wave); asm volatile("" : "+s"(F.wave)); F.tid = F.wave * 64 + F.lane;
#define PH_END   if (ph + 1 < hi) { if (!MK_PER_PHASE) xcd_barrier(relaunder_bar(bar)); } } ++ph;

    for (int L = 0; L < DEPTH_; ++L) {
        const int j = L >> 1; const bool moe = (L & 1) != 0;
#define HB ((bf16_t*)(ws + WS_H))
#define cnt ((int*)(ws + WS_CTL + CTL_CNT) + j * 16)
#define wgcnt ((int*)(ws + WS_CTL + 20480) + j * 2048)
        if (L == 0 || ((L - 1) & 1) == 0) {
        PH_BEGIN(0)
            if (L == 0) phase_prep_mixer(F, p, 0);
            if (L == 0) phase_norm<false, false>(F, p.x, p.norm_mix_g, bufA, nullptr, nullptr, nullptr, nullptr, nullptr, nullptr, nullptr, nullptr);
            else phase_norm_b8(F, HB, p.norm_mix_g + (size_t)L * 1024, bufA);
        PH_END
        }
        PH_BEGIN(1)
            pg8::Gemm g{bufA, (const bf16_t*)(ws + W_IN_(L)), 1024, 1024}; pg8::Order S; S.init(T_ / 256, 16, F.G, F.bid);
            pg8::EpiProj E{Qb, KVb, Ub, GTb, RATIOb, S1b};
            pg8::gemm_phase<pg8::EpiProj>(F.lds, F.wave, g, S, E);
        PH_END
        PH_BEGIN(2)
            if (F.bid < 64) { pg8::Gemm g{KVb, (const bf16_t*)(ws + W_C1_(L)), 1024, 2048}; pg8::Order S; S.init(64, 1, 64, F.bid); S.mode = 1; S.pbdiv = 32;
                pg8::EpiCmpH E{HCb, (const float*)(ws + W_B1_(L))};
                pg8::gemm_phase<pg8::EpiCmpH>(F.lds, F.wave, g, S, E);
                pg8::Unit u0; S.next(0, u0); asm volatile("s_waitcnt vmcnt(0)" ::: "memory"); __syncthreads();
                phase_cmp2(F, HCb, p.cmp_w2 + (size_t)L * 2 * 256 * 64, KCb, u0.pm * 4, u0.pm * 4 + 4, 1); }
            else { Ctx F2 = F; F2.bid = F.bid - 64; F2.G = F.G - 64;
                phase_pool(F2, Ub, bufA); phase_prep_ffn(F2, p, L); if (L + 1 < DEPTH_) phase_prep_mixer(F2, p, L + 1); }
        PH_END
        PH_BEGIN(4)
            phase_attn(F, Qb, KVb, KCb, GTb, bufA);
        PH_END
        PH_BEGIN(5)
            pg8::Gemm g{bufA, (const bf16_t*)(ws + W_M_(L)), 1024, 1024}; pg8::Order S; S.init(T_ / 256, 4, F.G, F.bid);
            pg8::EpiMerge E{RATIOb, S1b, MERGEDb};
            pg8::gemm_phase<pg8::EpiMerge>(F.lds, F.wave, g, S, E);
        PH_END
        PH_BEGIN(6)
            pg8::Gemm g{MERGEDb, (const bf16_t*)(ws + W_O_(L)), 1024, 1024}; pg8::Order S; S.init(T_ / 256, 4, F.G, F.bid);
            pg8::EpiResid E{(L == 0) ? (const void*)p.x : (const void*)HB, HB, L == 0};
            pg8::gemm_phase<pg8::EpiResid>(F.lds, F.wave, g, S, E);
        PH_END
        if (!moe) {
            PH_BEGIN(7)
                phase_norm_b8(F, HB, p.norm_ffn_g + (size_t)L * 1024, bufA);
            PH_END
            PH_BEGIN(8)
                pg8::Gemm g{bufA, (const bf16_t*)(ws + W_FF), 1024, 1024}; pg8::Order S; S.init(T_ / 256, 2 * DFF_ / 256, F.G, F.bid);
                pg8::EpiSwiglu E{(bf16_t*)(ws + R1_HF), DFF_};
                pg8::gemm_phase<pg8::EpiSwiglu>(F.lds, F.wave, g, S, E);
            PH_END
            PH_BEGIN(9)
                pg8::Gemm g{(const bf16_t*)(ws + R1_HF), (const bf16_t*)(ws + W_FFD_DENSE), DFF_, DFF_}; pg8::Order S; S.init(T_ / 256, 4, F.G, F.bid);
                pg8::EpiResid E{(const void*)HB, HB, false};
                pg8::gemm_phase<pg8::EpiResid>(F.lds, F.wave, g, S, E);
            PH_END
        } else {
            PH_BEGIN(10)
                phase_norm<true, true>(F, HB, p.norm_ffn_g + (size_t)L * 1024, bufA, p.moe_w_router + (size_t)j * 1024 * 8, p.moe_b_router + j * 8, wgcnt, tok_e, tok_p, tok_g, row_tok, row_dst);
            PH_END
            PH_BEGIN(11)
                phase_moe_assign(F, wgcnt, cnt, tok_e, tok_p, row_tok, row_dst);
            PH_END
            for (int s = 0; s < MOE_MAX_CHUNKS; ++s) {
                int ts[NE_ + 1]; const int NT = moe_tile_starts((const int*)(p0.ws + WS_CTL + CTL_CNT) + j * 16, ts);
                PH_BEGIN(13)
#define MOE_NTC(c_) ((NT - (c_) * MOE_CH_TILES) < 0 ? 0 : ((NT - (c_) * MOE_CH_TILES) > MOE_CH_TILES ? MOE_CH_TILES : (NT - (c_) * MOE_CH_TILES)))
#define MOE_HM(c_) (ws + ((c_) == MOE_NFULL ? WS_HM2 : (((c_) & 1) ? WS_HM1 : R1_HM)))
#define MOE_DOWN(c_) do { const int c = (c_); int ntc = MOE_NTC(c); if (c == MOE_NFULL && ntc > 8) ntc = 8; const int row0 = c * MOE_CH_TILES * 256; \
                        if (ntc > 0) { pg8::Gemm g{(const bf16_t*)MOE_HM(c), (const bf16_t*)(ws + W_FFD_MOE), DFE_, DFE_}; pg8::Order S; S.init(ntc, 4, F.G, F.bid); S.mode = 2; S.tile0 = c * MOE_CH_TILES; \
                            _Pragma("unroll") for (int k = 0; k <= NE_; ++k) S.ts[k] = ts[k]; \
                            pg8::EpiScatter E{(bf16_t*)(ws + R1_YB), row_dst + row0}; \
                            pg8::gemm_phase<pg8::EpiScatter>(F.lds, F.wave, g, S, E); } } while (0)
#define MOE_UP(c_, nskip_) do { const int c = (c_); int ntc = MOE_NTC(c); if (c == MOE_NFULL && ntc > 8) ntc = 8; const int row0 = c * MOE_CH_TILES * 256; \
                        if (ntc > 0) { pg8::Gemm g{bufA, (const bf16_t*)(ws + W_FF), 1024, 1024}; pg8::Order S; S.init(ntc, 2 * DFE_ / 256, F.G, F.bid); S.mode = 2; S.tile0 = c * MOE_CH_TILES; S.set_skip(nskip_); \
                            _Pragma("unroll") for (int k = 0; k <= NE_; ++k) S.ts[k] = ts[k]; \
                            pg8::EpiSwiglu E{(bf16_t*)MOE_HM(c), DFE_}; \
                            pg8::gemm_phase<pg8::EpiSwiglu, true>(F.lds, F.wave, g, S, E, row_tok + row0); } } while (0)
                    if (s == 0) { MOE_UP(MOE_NFULL, 0); MOE_UP(0, 0); }
                    else { int ntail = MOE_NTC(MOE_NFULL); ntail = ntail > 8 ? 8 : ntail;
                        if (s == 1) MOE_DOWN(MOE_NFULL);
                        MOE_DOWN(s - 1);
                        if (s < MOE_NFULL) MOE_UP(s, s == 1 ? 4 * ntail : 0); }
#undef MOE_NTC
#undef MOE_HM
#undef MOE_DOWN
#undef MOE_UP
                PH_END
            }
            PH_BEGIN(15)
                if (L + 1 < DEPTH_) phase_moe_combine(F, HB, nullptr, (const bf16_t*)(ws + R1_YB), tok_g, p.norm_mix_g + (size_t)(L + 1) * 1024, bufA);
                else phase_moe_combine(F, HB, p.out, (const bf16_t*)(ws + R1_YB), tok_g, p.final_norm_g, nullptr);
            PH_END
        }
    }
#undef PH_BEGIN
#undef PH_END
}

constexpr int N_PHASES = DEPTH_ * 6 - 1 + 2 * 3 + 2 * (2 + MOE_MAX_CHUNKS + 1);
constexpr int N_TYPES = 17;
constexpr unsigned ALL_TYPES = (1u << N_TYPES) - 1u;

typedef void (*kern_t)(Params);
template <int K> struct KernTab { static void fill(kern_t* t) { t[K] = fwd<(1u << K)>; KernTab<K - 1>::fill(t); } };
template <> struct KernTab<-1> { static void fill(kern_t*) {} };

extern "C" void kernel_launch(void* const* d_in, const int* in_sizes, int n_in, void* d_out, int out_size, void* d_ws, size_t ws_size, hipStream_t stream) {
    static int grid = 0;
    static kern_t ktab[N_TYPES + 1];
    static int ptype[N_PHASES];
    if (grid == 0) {
        if (n_in != 21 || out_size != T_ * D_ || ws_size < WS_END) { fprintf(stderr, "kernel_launch: unexpected problem (n_in %d out %d ws %zu need %zu)\n", n_in, out_size, ws_size, (size_t)WS_END); grid = -1; return; }
        int dev = 0, cus = 0;
        if (hipGetDevice(&dev) != hipSuccess || hipDeviceGetAttribute(&cus, hipDeviceAttributeMultiprocessorCount, dev) != hipSuccess) { grid = -1; return; }
#if MK_PER_PHASE
        KernTab<N_TYPES - 1>::fill(ktab);
        for (int k = 0; k < N_TYPES; ++k) if (hipFuncSetAttribute((const void*)ktab[k], hipFuncAttributeMaxDynamicSharedMemorySize, LDS_BYTES) != hipSuccess) { grid = -1; return; }
        { int n = 0; for (int L = 0; L < DEPTH_; ++L) { for (int k = 0; k < 7; ++k) if (k != 3 && (k > 0 || L != 2)) ptype[n++] = k;
              if ((L & 1) == 0) { ptype[n++] = 7; ptype[n++] = 8; ptype[n++] = 9; }
              else { ptype[n++] = 10; ptype[n++] = 11; for (int c = 0; c < MOE_MAX_CHUNKS; ++c) ptype[n++] = 13; ptype[n++] = 15; } }
          if (n != N_PHASES) { fprintf(stderr, "phase table mismatch %d\n", n); grid = -1; return; } }
#else
        ktab[N_TYPES] = fwd<ALL_TYPES>;
        if (hipFuncSetAttribute((const void*)ktab[N_TYPES], hipFuncAttributeMaxDynamicSharedMemorySize, LDS_BYTES) != hipSuccess) { grid = -1; return; }
        int per_cu = 0;
        if (hipOccupancyMaxActiveBlocksPerMultiprocessor(&per_cu, (const void*)ktab[N_TYPES], NTHR, LDS_BYTES) != hipSuccess || per_cu < 1) { fprintf(stderr, "kernel_launch: occupancy query reports %d\n", per_cu); }
        (void)hipGetLastError();
#endif
        grid = cus;
    }
    if (grid < 0) return;
    (void)hipMemsetAsync((char*)d_ws + WS_CTL, 0, CTL_BYTES, stream);
    Params p{};
    const float** pp = (const float**)&p;
    for (int i = 0; i < 21; ++i) pp[i] = (const float*)d_in[i];
    p.out = (float*)d_out; p.ws = (unsigned char*)d_ws;
#if MK_PER_PHASE
    for (int ph = 0; ph < N_PHASES; ++ph) { p.ph_lo = ph; p.ph_hi = ph + 1; hipLaunchKernelGGL(ktab[ptype[ph]], dim3(grid), dim3(NTHR), LDS_BYTES, stream, p); }
#else
    p.ph_lo = 0; p.ph_hi = N_PHASES; hipLaunchKernelGGL(ktab[N_TYPES], dim3(grid), dim3(NTHR), LDS_BYTES, stream, p);
#endif
}
```

```cpp
#include <hip/hip_runtime.h>
#include <cstdio>
#include <cstdint>

#ifndef GEMM_ALIGN_EPI
#define GEMM_ALIGN_EPI true
#endif
#ifndef MK_PER_PHASE
#define MK_PER_PHASE 0
#endif

#define LAS __attribute__((address_space(3)))
typedef unsigned short bf16_t;
typedef short bf16x8 __attribute__((ext_vector_type(8)));
typedef float f32x4 __attribute__((ext_vector_type(4)));
typedef float f32x2 __attribute__((ext_vector_type(2)));
typedef unsigned u32x4 __attribute__((ext_vector_type(4)));
typedef unsigned u32x2 __attribute__((ext_vector_type(2)));

constexpr int T_ = 65536, S_ = 2048, NB_ = 32, D_ = 1024, DEPTH_ = 4;
constexpr int INC_ = 3864;
constexpr int DFF_ = 2816, DFE_ = 3584, NE_ = 8;
constexpr int MOE_CH_TILES = 64;
constexpr int MOE_NFULL = 512 / MOE_CH_TILES;
constexpr int MOE_MAX_TILES = 520;
constexpr int MOE_MAX_CHUNKS = MOE_NFULL + 1;
constexpr int MOE_ROWS = MOE_MAX_TILES * 256;
constexpr int YB_DUMMY = 131072;

constexpr size_t WS_CTL = 0, CTL_BYTES = 65536;
constexpr size_t CTL_CNT = 16384;
constexpr size_t WS_BUFA = WS_CTL + CTL_BYTES;
constexpr size_t SZ_BUFA = (size_t)T_ * 1024 * 2;
constexpr size_t WS_R1 = WS_BUFA + SZ_BUFA;
constexpr size_t R1_Q = WS_R1;
constexpr size_t R1_KV = R1_Q + (size_t)T_ * 512 * 2;
constexpr size_t R1_U = R1_KV + (size_t)12 * T_ * 64 * 2 + 65536;
constexpr size_t R1_GT = R1_U + (size_t)T_ * 512 * 2;
constexpr size_t R1_RATIO = R1_GT + (size_t)T_ * 32 * 4;
constexpr size_t R1_S1 = R1_RATIO + (size_t)T_ * 1024 * 2;
constexpr size_t R1_END = R1_S1 + (size_t)T_ * 1024 * 2;
constexpr size_t R1_MERGED = R1_Q;
constexpr size_t R1_HF = WS_R1;
constexpr size_t R1_HM = WS_R1;
constexpr size_t R1_YB = R1_HM + (size_t)MOE_CH_TILES * 256 * DFE_ * 2;
constexpr size_t R1_YB_END = R1_YB + (size_t)(131072 + 256) * 1024 * 2;
static_assert(R1_YB_END <= R1_END, "moe overlay");
static_assert((size_t)T_ * DFF_ * 2 <= R1_END - WS_R1, "dense overlay");
constexpr size_t WS_HC = R1_END;
constexpr size_t WS_KC = WS_HC + (size_t)16384 * 256 * 2;
constexpr size_t WS_TOKE = WS_KC + (size_t)16384 * 64 * 2;
constexpr size_t WS_TOKP = WS_TOKE + (size_t)T_ * 2 * 4;
constexpr size_t WS_TOKG = WS_TOKP + (size_t)T_ * 2 * 4;
constexpr size_t WS_ROWT = WS_TOKG + (size_t)T_ * 2 * 4;
constexpr size_t WS_ROWD = WS_ROWT + (size_t)MOE_ROWS * 4 + 1024;
constexpr size_t WS_W = WS_ROWD + (size_t)MOE_ROWS * 4 + 1024;
constexpr size_t MIX_IN = 0;
constexpr size_t MIX_C1 = MIX_IN + (size_t)4096 * 1024 * 2;
constexpr size_t MIX_B1 = MIX_C1 + (size_t)2 * 256 * 2048 * 2;
constexpr size_t MIX_M = MIX_B1 + 4096;
constexpr size_t MIX_O = MIX_M + (size_t)1024 * 1024 * 2;
constexpr size_t MIX_BYTES = MIX_O + (size_t)1024 * 1024 * 2;
#define W_IN_(L) (WS_W + (size_t)((L) & 1) * MIX_BYTES + MIX_IN)
#define W_C1_(L) (WS_W + (size_t)((L) & 1) * MIX_BYTES + MIX_C1)
#define W_B1_(L) (WS_W + (size_t)((L) & 1) * MIX_BYTES + MIX_B1)
#define W_M_(L)  (WS_W + (size_t)((L) & 1) * MIX_BYTES + MIX_M)
#define W_O_(L)  (WS_W + (size_t)((L) & 1) * MIX_BYTES + MIX_O)
constexpr size_t W_FF = WS_W + 2 * MIX_BYTES;
constexpr size_t W_FFD_DENSE = W_FF + (size_t)2 * DFF_ * 1024 * 2;
constexpr size_t W_FFD_MOE = W_FF + (size_t)NE_ * 2 * DFE_ * 1024 * 2;
constexpr size_t WS_HM1 = W_FFD_MOE + (size_t)NE_ * 1024 * DFE_ * 2;
constexpr size_t WS_HM2 = WS_HM1 + (size_t)MOE_CH_TILES * 256 * DFE_ * 2;
constexpr size_t WS_H = WS_HM2 + (size_t)8 * 256 * DFE_ * 2;
constexpr size_t WS_END = WS_H + (size_t)T_ * 1024 * 2;
static_assert(WS_END <= (size_t)1157000000, "workspace budget (sum of the inputs = 1,157,673,024 bytes)");

__device__ __forceinline__ float bf2f(bf16_t v) { return __uint_as_float(((unsigned)v) << 16); }
__device__ __forceinline__ bf16_t f2bf(float f) { unsigned u = __float_as_uint(f); u += 0x7FFFu + ((u >> 16) & 1u); return (bf16_t)(u >> 16); }
__device__ __forceinline__ unsigned cvt_pk_bf16(float lo, float hi) { unsigned r; asm("v_cvt_pk_bf16_f32 %0, %1, %2" : "=v"(r) : "v"(lo), "v"(hi)); return r; }
__device__ __forceinline__ float wave_sum(float v) {
#pragma unroll
    for (int o = 32; o >= 1; o >>= 1) v += __shfl_xor(v, o);
    return v; }
__device__ __forceinline__ float wave_max(float v) {
#pragma unroll
    for (int o = 32; o >= 1; o >>= 1) v = fmaxf(v, __shfl_xor(v, o));
    return v; }
__device__ __forceinline__ float frcp(float x) { return __builtin_amdgcn_rcpf(x); }
__device__ __forceinline__ float fexpn(float x) { return __builtin_amdgcn_exp2f(x * -1.4426950408889634f); }
__device__ __forceinline__ float sigmoidf_(float x) { x = fminf(fmaxf(x, -30.f), 30.f); return frcp(1.0f + fexpn(x)); }
#define LDS_FENCE() asm volatile("s_waitcnt lgkmcnt(0)" ::: "memory")

#define XB_TMO      128
#define XB_XCNT(j)  (256  + 64 * (j))
#define XB_XSUB(j)  (1280 + 64 * (j))
#define XB_XGEN(j)  (2304 + 64 * (j))
#define XB_TOP      3328
#define XB_TOPGEN   3392
#define XCD_BAR_WORDS 3456
#define XB_SPIN_CAP (1u << 21)
__device__ __forceinline__ unsigned xb_ld(unsigned* p)              { return __hip_atomic_load(p, __ATOMIC_RELAXED, __HIP_MEMORY_SCOPE_AGENT); }
__device__ __forceinline__ unsigned xb_add(unsigned* p, unsigned v) { return __hip_atomic_fetch_add(p, v, __ATOMIC_RELAXED, __HIP_MEMORY_SCOPE_AGENT); }
__device__ __forceinline__ unsigned xb_xcc_id() { return (unsigned)__builtin_amdgcn_s_getreg((3 << 11) | 20) & 0xFu; }
#define XB_SPIN(cond, bar) do { unsigned _sp = 0; while (cond) { __builtin_amdgcn_s_sleep(1); \
    if ((++_sp & 255u) == 0u) { if (xb_ld(&(bar)[XB_TMO])) break; if (_sp > XB_SPIN_CAP) { atomicAdd(&(bar)[XB_TMO], 1u); break; } } } } while (0)
struct XcdBarrier { unsigned* bar; unsigned x; volatile LAS unsigned* st; };
__device__ __forceinline__ XcdBarrier xcd_barrier_post(unsigned* bar, volatile LAS unsigned* st) {
    XcdBarrier b; b.bar = bar; b.x = xb_xcc_id(); b.st = st;
    if (threadIdx.x == 0) (void)xb_add(&bar[XB_XCNT(b.x)], 1u);
    return b;
}
__device__ __forceinline__ void xcd_barrier_complete(unsigned* bar, unsigned x, unsigned& nloc, unsigned& nx) {
    asm volatile("" : "+s"(x));
    const unsigned G = gridDim.x * gridDim.y * gridDim.z;
    unsigned sum, cnt, mine, sp = 0u;
    for (;;) {
        sum = 0u; cnt = 0u; mine = 0u;
#pragma unroll
        for (unsigned j = 0; j < 16; ++j) { const unsigned c = xb_ld(&bar[XB_XCNT(j)]); sum += c; cnt += (c > 0u) ? 1u : 0u; mine = (j == x) ? c : mine; }
        if (sum == G) break;
        __builtin_amdgcn_s_sleep(1);
        if ((++sp & 255u) == 0u) { if (xb_ld(&bar[XB_TMO])) break; if (sp > XB_SPIN_CAP) { atomicAdd(&bar[XB_TMO], 1u); break; } }
    }
    nloc = mine > 0u ? mine : 1u; nx = cnt > 0u ? cnt : 1u;
}
__device__ __forceinline__ void xcd_barrier(const XcdBarrier& b) {
    asm volatile("s_waitcnt vmcnt(0)" ::: "memory");
    __syncthreads();
    if (threadIdx.x == 0) {
        unsigned* bar = b.bar;
        __builtin_amdgcn_s_waitcnt(0);
        unsigned nloc = b.st[0], nx = b.st[1];
        if (nloc == 0u) { xcd_barrier_complete(bar, b.x, nloc, nx); b.st[0] = nloc; b.st[1] = nx; }
        const unsigned old = xb_add(&bar[XB_XSUB(b.x)], 1u);
        const unsigned gen = old / nloc;
        if (old + 1u == (gen + 1u) * nloc) {
            __builtin_amdgcn_fence(__ATOMIC_RELEASE, "agent");
            asm volatile("s_waitcnt vmcnt(0)" ::: "memory");
            const unsigned og = xb_add(&bar[XB_TOP], 1u);
            const unsigned tg = og / nx;
            if (og + 1u == (tg + 1u) * nx) xb_add(&bar[XB_TOPGEN], 1u);
            else XB_SPIN(xb_ld(&bar[XB_TOPGEN]) == tg, bar);
            __builtin_amdgcn_fence(__ATOMIC_ACQUIRE, "agent");
            xb_add(&bar[XB_XGEN(b.x)], 1u);
            asm volatile("s_waitcnt vmcnt(0)" ::: "memory");
        } else {
            XB_SPIN(xb_ld(&bar[XB_XGEN(b.x)]) == gen, bar);
            __builtin_amdgcn_fence(__ATOMIC_ACQUIRE, "agent");
            asm volatile("s_waitcnt vmcnt(0)" ::: "memory");
        }
    }
    __syncthreads();
}

namespace pg8 {
constexpr int BM = 256, BK = 64, HALF = 128, HTB = HALF * BK * 2, STAGE_BYTES = 8 * HTB, NXCD = 8, WGM = 8;
__host__ __device__ __forceinline__ int lds_byte(int r, int c) { const int st = (r >> 4) * 2 + (c >> 5), rr = r & 15, cc = c & 31, ob = rr * 64 + cc * 2; return st * 1024 + (ob ^ (((ob >> 9) & 1) << 5)); }
__host__ __device__ __forceinline__ void stage_rc(int b, int& R, int& C) { const int st = b / 1024, sb = b % 1024, swz = sb ^ (((sb >> 9) & 1) << 5); R = (st >> 1) * 16 + swz / 64; C = (st & 1) * 32 + (swz % 64) / 2; }
__host__ __device__ __forceinline__ int perm32(int rho) { const int n = rho >> 4, i = rho & 15; return 8 * (i >> 2) + 4 * n + (i & 3); }

struct Unit { int pm, pn, pb; };
struct Gemm { const bf16_t* A; const bf16_t* Bt; int lda, K; };

struct Order {
    int nM, nN, nwg, G, c, mode, pbdiv, tile0, nsk; int ts[NE_ + 1];
    __device__ __forceinline__ void init(int nM_, int nN_, int G_, int c_) { nM = nM_; nN = nN_; nwg = nM * nN; G = G_; c = c_; mode = 0; pbdiv = 1; tile0 = 0; nsk = 0; }
    __device__ __forceinline__ void set_skip(int n) { nsk = (n > 0 && n * 5 <= G && nwg >= 6 * G) ? n : 0; }
    __device__ __forceinline__ bool next(int i, Unit& u) const {
        long L = (long)i * G + c;
        if (nsk > 0) { if (c < nsk) L += 4L * G;
            else if (L >= nwg) { const int e = c - (G - 4 * nsk); if (e < 0 || L - G >= nwg) return false; L = (long)(e & 3) * G + (e >> 2); } }
        if (L >= nwg) return false;
        int wgid = (int)L; { const int q = nwg / NXCD, r = nwg % NXCD, xcd = wgid % NXCD, off = wgid / NXCD; wgid = (xcd < r ? xcd * (q + 1) : r * (q + 1) + (xcd - r) * q) + off; }
        const int nig = WGM * nN, gid = wgid / nig, fm = gid * WGM, gsz = (nM - fm) < WGM ? (nM - fm) : WGM;
        u.pm = fm + ((wgid % nig) % gsz); u.pn = (wgid % nig) / gsz;
        if (mode == 0) u.pb = u.pn;
        else if (mode == 1) u.pb = (u.pm / pbdiv) * nN + u.pn;
        else { const int tile = tile0 + u.pm; int e = 0;
#pragma unroll
            for (int k = 1; k < NE_; ++k) e += (tile >= ts[k]) ? 1 : 0;
            u.pb = e * nN + u.pn; }
        return true;
    }
};

template <class Epi, bool GATHER = false>
__device__ __forceinline__ void gemm_phase(LAS unsigned char* lds, int wave_id, const Gemm g, const Order& S, const Epi& E, const int* rowtok = nullptr) {
    int lane; asm volatile("v_mbcnt_lo_u32_b32 %0, -1, 0\n\tv_mbcnt_hi_u32_b32 %0, -1, %0" : "=v"(lane));
    const int wid = wave_id, tid = wid * 64 + lane, wr = wid >> 2, wc = wid & 3, fr = lane & 15, fq = lane >> 4;
    const int K = g.K, lda = g.lda, nt = K / BK; constexpr bool ALIGN_EPI = GEMM_ALIGN_EPI;
    unsigned vA[2][2], voffB[2]; LAS int* gtab = (LAS int*)(lds + STAGE_BYTES + 2048);
    const size_t kstep = (size_t)(BK * 2);
    const size_t hstepA = (size_t)HALF * lda * 2, hstepB = (size_t)HALF * K * 2;
    const size_t tstepA = GATHER ? 0 : 2 * hstepA, tstepB = 2 * hstepB;
#pragma unroll
    for (int i = 0; i < 2; ++i) { int R, C; stage_rc(tid * 16 + i * 8192, R, C); const int Rb = Epi::PERM ? ((R & ~31) + perm32(R & 31)) : R;
        vA[0][i] = (unsigned)(R * lda + C) * 2u; vA[1][i] = vA[0][i] + (unsigned)hstepA; voffB[i] = (unsigned)(Rb * K + C) * 2u; }
#define PG8_LOADVA(dst, pm_) do { int t2_ = tid; asm volatile("" : "+v"(t2_)); _Pragma("unroll") for (int i_ = 0; i_ < 2; ++i_) { int R_, C_; stage_rc(t2_ * 16 + i_ * 8192, R_, C_); \
        _Pragma("unroll") for (int h_ = 0; h_ < 2; ++h_) dst[h_][i_] = (unsigned)rowtok[(pm_) * 256 + 128 * h_ + R_] * (unsigned)(lda * 2) + (unsigned)(C_ * 2); } } while (0)
    const unsigned ldsw = (unsigned)wid * 1024u;
    const int aoff = lds_byte(wr * 64 + fr, fq * 8), boff = lds_byte(wc * 32 + fr, fq * 8);
#define PG8_SA(b, h) (((b) * 2 + (h)) * HTB)
#define PG8_SB(b, h) ((4 + (b) * 2 + (h)) * HTB)
#define PG8_STAGE(bufoff, gbase, voff) do { _Pragma("unroll") for (int _i = 0; _i < 2; ++_i) \
        __builtin_amdgcn_global_load_lds((const unsigned*)((const char*)(gbase) + (voff)[_i]), (LAS unsigned*)(lds + (bufoff) + ldsw + _i * 8192), 16, 0, 0); } while (0)
#define PG8_LDA(dst, b, h) do { _Pragma("unroll") for (int m = 0; m < 4; ++m) _Pragma("unroll") for (int k = 0; k < 2; ++k) dst[m][k] = *(const LAS bf16x8*)(lds + PG8_SA(b, h) + aoff + m * 2048 + k * 1024); } while (0)
#define PG8_LDB(dst, b, h) do { _Pragma("unroll") for (int n = 0; n < 2; ++n) _Pragma("unroll") for (int k = 0; k < 2; ++k) dst[n][k] = *(const LAS bf16x8*)(lds + PG8_SB(b, h) + boff + n * 2048 + k * 1024); } while (0)
#define PG8_MMA(ai, bj, At, Bt) do { __builtin_amdgcn_s_setprio(1); _Pragma("unroll") for (int m = 0; m < 4; ++m) _Pragma("unroll") for (int n = 0; n < 2; ++n) _Pragma("unroll") for (int k = 0; k < 2; ++k) \
        acc[ai][bj][m][n] = __builtin_amdgcn_mfma_f32_16x16x32_bf16(Bt[n][k], At[m][k], acc[ai][bj][m][n], 0, 0, 0); __builtin_amdgcn_s_setprio(0); } while (0)
#define PG8_WAIT_V(n) asm volatile("s_waitcnt vmcnt(" #n ")" ::: "memory")
#define PG8_WAIT_L(n) asm volatile("s_waitcnt lgkmcnt(" #n ")" ::: "memory")
#define PG8_BAR __builtin_amdgcn_s_barrier()
#define PG8_SCHED __builtin_amdgcn_sched_barrier(0)
    Unit cur, nxt; int ui = 0;
    if (!S.next(0, cur)) return;
    f32x4 acc[2][2][4][2];
#pragma unroll
    for (int a = 0; a < 2; ++a)
#pragma unroll
        for (int b = 0; b < 2; ++b)
#pragma unroll
            for (int m = 0; m < 4; ++m)
#pragma unroll
                for (int n = 0; n < 2; ++n) acc[a][b][m][n] = (f32x4){0.f, 0.f, 0.f, 0.f};
    bf16x8 At[4][2], B0[2][2], B1[2][2];
    const char* cA = (const char*)g.A + (size_t)cur.pm * tstepA; const char* cB = (const char*)g.Bt + (size_t)cur.pb * tstepB;
    if constexpr (GATHER) { PG8_LOADVA(vA, cur.pm); }
    PG8_STAGE(PG8_SB(0, 0), cB, voffB); PG8_STAGE(PG8_SB(0, 1), cB + hstepB, voffB); PG8_STAGE(PG8_SA(0, 0), cA, vA[0]); PG8_STAGE(PG8_SA(0, 1), cA, vA[1]);
    if (wr == 1) PG8_BAR;
    PG8_WAIT_V(2); PG8_BAR;
    PG8_STAGE(PG8_SB(1, 0), cB + kstep, voffB); PG8_STAGE(PG8_SA(1, 0), cA + kstep, vA[0]); PG8_STAGE(PG8_SB(1, 1), cB + hstepB + kstep, voffB);
    PG8_WAIT_V(6); PG8_BAR;
    for (;;) {
        const bool has_next = S.next(ui + 1, nxt);
        const char* nA = has_next ? (const char*)g.A + (size_t)nxt.pm * tstepA : cA; const char* nB = has_next ? (const char*)g.Bt + (size_t)nxt.pb * tstepB : cB;
        if constexpr (GATHER) { if (has_next && wid < 4)
            __builtin_amdgcn_global_load_lds((const unsigned*)(rowtok + nxt.pm * 256 + tid), (LAS unsigned*)(gtab + wid * 64), 4, 0, 0); }
        for (int t = 0; t < nt; t += 2) {
            const bool last = (t == nt - 2);
            const char* a1 = cA + (size_t)(t + 1) * kstep;
            const char* a2 = last ? nA : cA + (size_t)(t + 2) * kstep; const char* b2 = last ? nB : cB + (size_t)(t + 2) * kstep;
            const char* a3 = a2 + kstep; const char* b3 = b2 + kstep;
            if constexpr (Epi::MIDK) { if (t == Epi::MID_T) { if (ALIGN_EPI && wr == 0) PG8_BAR; int fr2 = fr, fq2 = fq; asm volatile("" : "+v"(fr2), "+v"(fq2)); E.mid(acc, cur, wr, wc, fr2, fq2); if (ALIGN_EPI && wr == 1) PG8_BAR; } }
            PG8_LDB(B0, 0, 0); PG8_LDB(B1, 0, 1); PG8_SCHED; PG8_LDA(At, 0, 0); PG8_STAGE(PG8_SA(1, 1), a1, vA[1]);
            if constexpr (GATHER) { if (last && has_next) { int t2_ = tid; asm volatile("" : "+v"(t2_));
#pragma unroll
                for (int i_ = 0; i_ < 2; ++i_) { int R_, C_; stage_rc(t2_ * 16 + i_ * 8192, R_, C_);
                    vA[0][i_] = (unsigned)gtab[R_] * (unsigned)(lda * 2) + (unsigned)(C_ * 2); vA[1][i_] = (unsigned)gtab[128 + R_] * (unsigned)(lda * 2) + (unsigned)(C_ * 2); } } }
            PG8_WAIT_V(8); PG8_WAIT_L(0); PG8_BAR; PG8_MMA(0, 0, At, B0); PG8_MMA(0, 1, At, B1); PG8_BAR; PG8_SCHED;
            PG8_LDA(At, 0, 1); PG8_STAGE(PG8_SB(0, 0), b2, voffB); PG8_STAGE(PG8_SB(0, 1), b2 + hstepB, voffB); PG8_STAGE(PG8_SA(0, 0), a2, vA[0]);
            PG8_WAIT_V(8); PG8_WAIT_L(0); PG8_BAR; PG8_MMA(1, 0, At, B0); PG8_MMA(1, 1, At, B1); PG8_BAR; PG8_SCHED;
            PG8_LDB(B0, 1, 0); PG8_LDB(B1, 1, 1); PG8_SCHED; PG8_LDA(At, 1, 0); PG8_STAGE(PG8_SA(0, 1), a2, vA[1]);
            PG8_WAIT_V(8); PG8_WAIT_L(0); PG8_BAR; PG8_MMA(0, 0, At, B0); PG8_MMA(0, 1, At, B1); PG8_BAR; PG8_SCHED;
            PG8_LDA(At, 1, 1); PG8_STAGE(PG8_SB(1, 0), b3, voffB); PG8_STAGE(PG8_SB(1, 1), b3 + hstepB, voffB); PG8_STAGE(PG8_SA(1, 0), a3, vA[0]);
            PG8_WAIT_V(8); PG8_WAIT_L(0); PG8_BAR; PG8_MMA(1, 0, At, B0); PG8_MMA(1, 1, At, B1); PG8_BAR; PG8_SCHED;
        }
        if constexpr (ALIGN_EPI) { if (wr == 0) PG8_BAR; }
        { int fr2 = fr, fq2 = fq; asm volatile("" : "+v"(fr2), "+v"(fq2)); E(acc, cur, wr, wc, fr2, fq2); }
        if (!has_next) break;
#pragma unroll
        for (int a = 0; a < 2; ++a)
#pragma unroll
            for (int b = 0; b < 2; ++b)
#pragma unroll
                for (int m = 0; m < 4; ++m)
#pragma unroll
                    for (int n = 0; n < 2; ++n) acc[a][b][m][n] = (f32x4){0.f, 0.f, 0.f, 0.f};
        cur = nxt; cA = nA; cB = nB; ++ui;
        if constexpr (ALIGN_EPI) { if (wr == 1) PG8_BAR; }
    }
    PG8_WAIT_V(0);
    if constexpr (!ALIGN_EPI) { if (wr == 0) PG8_BAR; }
    PG8_BAR;
#undef PG8_LOADVA
#undef PG8_SA
#undef PG8_SB
#undef PG8_STAGE
#undef PG8_LDA
#undef PG8_LDB
#undef PG8_MMA
#undef PG8_WAIT_V
#undef PG8_WAIT_L
#undef PG8_BAR
#undef PG8_SCHED
}

typedef f32x4 Acc[2][2][4][2];
__device__ __forceinline__ u32x4 pack8(const f32x4 a, const f32x4 b) { u32x4 w; w.x = cvt_pk_bf16(a[0], a[1]); w.y = cvt_pk_bf16(a[2], a[3]); w.z = cvt_pk_bf16(b[0], b[1]); w.w = cvt_pk_bf16(b[2], b[3]); return w; }
__device__ __forceinline__ void unpack8(const u32x4 w, f32x4& a, f32x4& b) {
    a[0] = __uint_as_float(w.x << 16); a[1] = __uint_as_float(w.x & 0xffff0000u); a[2] = __uint_as_float(w.y << 16); a[3] = __uint_as_float(w.y & 0xffff0000u);
    b[0] = __uint_as_float(w.z << 16); b[1] = __uint_as_float(w.z & 0xffff0000u); b[2] = __uint_as_float(w.w << 16); b[3] = __uint_as_float(w.w & 0xffff0000u); }

struct EpiProj {
    static constexpr bool PERM = true, MIDK = false; static constexpr int MID_T = 0;
    bf16_t* Q; bf16_t* KV; bf16_t* U; float* GT; bf16_t* RATIO; bf16_t* S1;
    __device__ __forceinline__ void mid(Acc&, const Unit&, int, int, int, int) const {}
    __device__ __forceinline__ void operator()(const Acc& acc, const Unit& u, int wr, int wc, int fr, int fq) const {
        const int row0 = u.pm * BM + wr * 64 + fr, pn = u.pn;
        if (pn < 7) {
            bf16_t* b0; size_t bstep; int ld; float sc = 1.0f; const int lc = wc * 32 + 8 * fq;
            if (pn < 2) { b0 = Q + pn * 256 + lc; bstep = 128; ld = 512; sc = 0.125f * 1.4426950408889634f; }
            else if (pn < 5) { const int gg = wc >> 1, d = (wc & 1) * 32 + 8 * fq; b0 = KV + ((size_t)((2 * (pn - 2)) * 2 + gg) * T_) * 64 + d; bstep = (size_t)2 * T_ * 64; ld = 64; }
            else { b0 = U + (pn - 5) * 256 + lc; bstep = 128; ld = 512; }
#pragma unroll
            for (int ai = 0; ai < 2; ++ai)
#pragma unroll
                for (int m = 0; m < 4; ++m) { bf16_t* rp = b0 + (size_t)(row0 + ai * HALF + m * 16) * ld;
                    *(u32x4*)(rp) = pack8(acc[ai][0][m][0] * sc, acc[ai][0][m][1] * sc); *(u32x4*)(rp + bstep) = pack8(acc[ai][1][m][0] * sc, acc[ai][1][m][1] * sc); }
        } else if (pn < 15) {
#pragma unroll
            for (int ai = 0; ai < 2; ++ai)
#pragma unroll
                for (int m = 0; m < 4; ++m) {
                    f32x4 r0, r1, s0, s1;
#pragma unroll
                    for (int j = 0; j < 4; ++j) {
                        { const float l0 = fminf(fmaxf(acc[ai][0][m][0][j], -30.f), 30.f), l1 = fminf(fmaxf(acc[ai][1][m][0][j], -30.f), 30.f);
                          const float e0 = 1.0f + fexpn(l0), e1 = 1.0f + fexpn(l1); r0[j] = e1 * frcp(e0); s0[j] = frcp(e1); }
                        { const float l0 = fminf(fmaxf(acc[ai][0][m][1][j], -30.f), 30.f), l1 = fminf(fmaxf(acc[ai][1][m][1][j], -30.f), 30.f);
                          const float e0 = 1.0f + fexpn(l0), e1 = 1.0f + fexpn(l1); r1[j] = e1 * frcp(e0); s1[j] = frcp(e1); }
                    }
                    const size_t o = ((((size_t)(u.pm * 8 + pn - 7) * 8 + wr * 4 + wc) * 8 + ai * 4 + m) * 64 + fq * 16 + fr) * 8;
                    *(u32x4*)(RATIO + o) = pack8(r0, r1); *(u32x4*)(S1 + o) = pack8(s0, s1);
                }
        } else {
            if (wc == 0 && fq < 3) {
#pragma unroll
                for (int ai = 0; ai < 2; ++ai)
#pragma unroll
                    for (int m = 0; m < 4; ++m) { f32x4 a, b;
#pragma unroll
                        for (int j = 0; j < 4; ++j) { a[j] = sigmoidf_(acc[ai][0][m][0][j]); b[j] = sigmoidf_(acc[ai][0][m][1][j]); }
                        float* gp = GT + (size_t)(row0 + ai * HALF + m * 16) * 32 + 8 * fq; *(f32x4*)(gp) = a; *(f32x4*)(gp + 4) = b; }
            }
        }
    }
};
struct EpiCmpH {
    static constexpr bool PERM = true, MIDK = false; static constexpr int MID_T = 0;
    bf16_t* HC; const float* bias;
    __device__ __forceinline__ void mid(Acc&, const Unit&, int, int, int, int) const {}
    __device__ __forceinline__ void operator()(const Acc& acc, const Unit& u, int wr, int wc, int fr, int fq) const {
        const int row0 = u.pm * BM + wr * 64 + fr; const float* bp = bias + u.pb * 256;
#pragma unroll
        for (int bj = 0; bj < 2; ++bj) { const int c0 = bj * 128 + wc * 32 + 8 * fq; const f32x4 b0 = *(const f32x4*)(bp + c0), b1 = *(const f32x4*)(bp + c0 + 4);
#pragma unroll
            for (int ai = 0; ai < 2; ++ai)
#pragma unroll
                for (int m = 0; m < 4; ++m) { f32x4 x0 = acc[ai][bj][m][0] + b0, x1 = acc[ai][bj][m][1] + b1;
#pragma unroll
                    for (int j = 0; j < 4; ++j) { const float a = x0[j], b = x1[j];
                        x0[j] = a * frcp(1.0f + fexpn(1.5957691216f * (a + 0.044715f * a * a * a)));
                        x1[j] = b * frcp(1.0f + fexpn(1.5957691216f * (b + 0.044715f * b * b * b))); }
                    *(u32x4*)(HC + (size_t)(row0 + ai * HALF + m * 16) * 256 + c0) = pack8(x0, x1); } }
    }
};
struct EpiMerge {
    static constexpr bool PERM = true, MIDK = true; static constexpr int MID_T = 8;
    const bf16_t* RATIO; const bf16_t* S1; bf16_t* OUT;
    __device__ __forceinline__ size_t gimg(int row0, int col0, int bj) const { const int pm = row0 >> 8, wr = (row0 >> 6) & 1, fr = row0 & 15, pn = col0 >> 8, wc = (col0 >> 5) & 3, fq = (col0 >> 3) & 3;
        return ((((size_t)(pm * 8 + 2 * pn + bj) * 8 + wr * 4 + wc) * 8) * 64 + fq * 16 + fr) * 8; }
    __device__ __forceinline__ void load8(const bf16_t* P, int row0, int col0, int ai, u32x4 (&w)[8]) const {
#pragma unroll
        for (int m = 0; m < 4; ++m)
#pragma unroll
            for (int bj = 0; bj < 2; ++bj) w[m * 2 + bj] = *(const u32x4*)(P + gimg(row0, col0, bj) + (ai * 4 + m) * 512);
        asm volatile("" : "+v"(w[0]), "+v"(w[1]), "+v"(w[2]), "+v"(w[3]), "+v"(w[4]), "+v"(w[5]), "+v"(w[6]), "+v"(w[7]));
    }
    __device__ __forceinline__ void mid(Acc& acc, const Unit& u, int wr, int wc, int fr, int fq) const {
        const int row0 = u.pm * BM + wr * 64 + fr, col0 = u.pn * BM + wc * 32 + 8 * fq;
        u32x4 w0[8], w1[8];
#pragma unroll
        for (int m = 0; m < 4; ++m)
#pragma unroll
            for (int bj = 0; bj < 2; ++bj) { w0[m * 2 + bj] = *(const u32x4*)(RATIO + gimg(row0, col0, bj) + m * 512); w1[m * 2 + bj] = *(const u32x4*)(RATIO + gimg(row0, col0, bj) + (4 + m) * 512); }
        asm volatile("" : "+v"(w0[0]), "+v"(w0[1]), "+v"(w0[2]), "+v"(w0[3]), "+v"(w0[4]), "+v"(w0[5]), "+v"(w0[6]), "+v"(w0[7]));
        asm volatile("" : "+v"(w1[0]), "+v"(w1[1]), "+v"(w1[2]), "+v"(w1[3]), "+v"(w1[4]), "+v"(w1[5]), "+v"(w1[6]), "+v"(w1[7]));
#pragma unroll
        for (int m = 0; m < 4; ++m)
#pragma unroll
            for (int bj = 0; bj < 2; ++bj) { f32x4 a, b; unpack8(w0[m * 2 + bj], a, b); acc[0][bj][m][0] *= a; acc[0][bj][m][1] *= b; unpack8(w1[m * 2 + bj], a, b); acc[1][bj][m][0] *= a; acc[1][bj][m][1] *= b; }
    }
    __device__ __forceinline__ void operator()(const Acc& acc, const Unit& u, int wr, int wc, int fr, int fq) const {
        const int row0 = u.pm * BM + wr * 64 + fr, col0 = u.pn * BM + wc * 32 + 8 * fq;
#pragma unroll
        for (int ai = 0; ai < 2; ++ai) { u32x4 w[8]; load8(S1, row0, col0, ai, w);
#pragma unroll
            for (int m = 0; m < 4; ++m)
#pragma unroll
                for (int bj = 0; bj < 2; ++bj) { const size_t o = (size_t)(row0 + ai * HALF + m * 16) * 1024 + col0 + bj * HALF; f32x4 a, b; unpack8(w[m * 2 + bj], a, b);
                    *(u32x4*)(OUT + o) = pack8(acc[ai][bj][m][0] * a, acc[ai][bj][m][1] * b); } }
    }
};
struct EpiResid {
    static constexpr bool PERM = true, MIDK = false; static constexpr int MID_T = 0;
    const void* hin; bf16_t* hout; bool in_f32;
    __device__ __forceinline__ void mid(Acc&, const Unit&, int, int, int, int) const {}
    __device__ __forceinline__ void operator()(const Acc& acc, const Unit& u, int wr, int wc, int fr, int fq) const {
        const int row0 = u.pm * BM + wr * 64 + fr, col0 = u.pn * BM + wc * 32 + 8 * fq;
        if (in_f32) {
#pragma unroll
            for (int ai = 0; ai < 2; ++ai)
#pragma unroll
                for (int mh = 0; mh < 2; ++mh) { f32x4 w[8];
#pragma unroll
                    for (int m2 = 0; m2 < 2; ++m2)
#pragma unroll
                        for (int bj = 0; bj < 2; ++bj) { const size_t off = (size_t)(row0 + ai * HALF + (mh * 2 + m2) * 16) * 1024 + col0 + bj * HALF; w[(m2 * 2 + bj) * 2] = *(const f32x4*)((const float*)hin + off); w[(m2 * 2 + bj) * 2 + 1] = *(const f32x4*)((const float*)hin + off + 4); }
                    asm volatile("" : "+v"(w[0]), "+v"(w[1]), "+v"(w[2]), "+v"(w[3]), "+v"(w[4]), "+v"(w[5]), "+v"(w[6]), "+v"(w[7]));
#pragma unroll
                    for (int m2 = 0; m2 < 2; ++m2)
#pragma unroll
                        for (int bj = 0; bj < 2; ++bj) { const int m = mh * 2 + m2; const size_t off = (size_t)(row0 + ai * HALF + m * 16) * 1024 + col0 + bj * HALF;
                            *(u32x4*)(hout + off) = pack8(w[(m2 * 2 + bj) * 2] + acc[ai][bj][m][0], w[(m2 * 2 + bj) * 2 + 1] + acc[ai][bj][m][1]); } }
        } else { u32x4 w0[8], w1[8];
            bf16_t* hb = hout + (size_t)row0 * 1024 + col0;
#pragma unroll
            for (int m = 0; m < 4; ++m)
#pragma unroll
                for (int bj = 0; bj < 2; ++bj) { w0[m * 2 + bj] = *(const u32x4*)(hb + (m * 16) * 1024 + bj * HALF); w1[m * 2 + bj] = *(const u32x4*)(hb + (HALF + m * 16) * 1024 + bj * HALF); }
            asm volatile("" : "+v"(w0[0]), "+v"(w0[1]), "+v"(w0[2]), "+v"(w0[3]), "+v"(w0[4]), "+v"(w0[5]), "+v"(w0[6]), "+v"(w0[7]));
            asm volatile("" : "+v"(w1[0]), "+v"(w1[1]), "+v"(w1[2]), "+v"(w1[3]), "+v"(w1[4]), "+v"(w1[5]), "+v"(w1[6]), "+v"(w1[7]));
#pragma unroll
            for (int ai = 0; ai < 2; ++ai)
#pragma unroll
                for (int m = 0; m < 4; ++m)
#pragma unroll
                    for (int bj = 0; bj < 2; ++bj) { f32x4 a, b; unpack8(ai ? w1[m * 2 + bj] : w0[m * 2 + bj], a, b);
                        *(u32x4*)(hb + (ai * HALF + m * 16) * 1024 + bj * HALF) = pack8(a + acc[ai][bj][m][0], b + acc[ai][bj][m][1]); }
        }
    }
};
struct EpiSwiglu {
    static constexpr bool PERM = true, MIDK = false; static constexpr int MID_T = 0;
    bf16_t* H; int ldh;
    __device__ __forceinline__ void mid(Acc&, const Unit&, int, int, int, int) const {}
    __device__ __forceinline__ void operator()(const Acc& acc, const Unit& u, int wr, int wc, int fr, int fq) const {
        const int row0 = u.pm * BM + wr * 64 + fr, col0 = u.pn * 128 + wc * 32 + 8 * fq;
#pragma unroll
        for (int ai = 0; ai < 2; ++ai)
#pragma unroll
            for (int m = 0; m < 4; ++m) { f32x4 x0, x1;
#pragma unroll
                for (int j = 0; j < 4; ++j) { const float g0 = acc[ai][0][m][0][j], g1 = acc[ai][0][m][1][j];
                    x0[j] = g0 * frcp(1.0f + fexpn(g0)) * acc[ai][1][m][0][j]; x1[j] = g1 * frcp(1.0f + fexpn(g1)) * acc[ai][1][m][1][j]; }
                *(u32x4*)(H + (size_t)(row0 + ai * HALF + m * 16) * ldh + col0) = pack8(x0, x1); }
    }
};
struct EpiScatter {
    static constexpr bool PERM = true, MIDK = false; static constexpr int MID_T = 0;
    bf16_t* YB; const int* row_dst;
    __device__ __forceinline__ void mid(Acc&, const Unit&, int, int, int, int) const {}
    __device__ __forceinline__ void operator()(const Acc& acc, const Unit& u, int wr, int wc, int fr, int fq) const {
        const int row0 = u.pm * BM + wr * 64 + fr, col0 = u.pn * BM + wc * 32 + 8 * fq;
        int dst[8];
#pragma unroll
        for (int ai = 0; ai < 2; ++ai)
#pragma unroll
            for (int m = 0; m < 4; ++m) dst[ai * 4 + m] = row_dst[row0 + ai * HALF + m * 16];
        asm volatile("" : "+v"(dst[0]), "+v"(dst[1]), "+v"(dst[2]), "+v"(dst[3]), "+v"(dst[4]), "+v"(dst[5]), "+v"(dst[6]), "+v"(dst[7]));
#pragma unroll
        for (int ai = 0; ai < 2; ++ai)
#pragma unroll
            for (int m = 0; m < 4; ++m) {
#pragma unroll
                for (int bj = 0; bj < 2; ++bj) *(u32x4*)(YB + (size_t)dst[ai * 4 + m] * 1024 + col0 + bj * HALF) = pack8(acc[ai][bj][m][0], acc[ai][bj][m][1]); }
    }
};
}

struct Params {
    const float* x; const float* norm_mix_g; const float* w_in; const float* cmp_pos; const float* cmp_w1; const float* cmp_w2; const float* w_nsa_up;
    const float* pool_w; const float* pool_scale; const float* w_pool_up; const float* w_out; const float* norm_ffn_g;
    const float* ffn_w_gate; const float* ffn_w_up; const float* ffn_w_down; const float* moe_w_router; const float* moe_b_router;
    const float* moe_w_gate; const float* moe_w_up; const float* moe_w_down; const float* final_norm_g;
    float* out; unsigned char* ws;
    int ph_lo, ph_hi;
};

__device__ __forceinline__ void load_params(Params& p) {
#if defined(__HIP_DEVICE_COMPILE__)
    typedef const __attribute__((address_space(4))) unsigned long long* cptr_t;
    typedef __attribute__((address_space(1))) const float* gcf; typedef __attribute__((address_space(1))) float* gf; typedef __attribute__((address_space(1))) unsigned char* guc;
    cptr_t q = (cptr_t)__builtin_amdgcn_kernarg_segment_ptr(); asm volatile("" : "+s"(q));
    p.x = (const float*)(gcf)q[0];
    p.norm_mix_g = (const float*)(gcf)q[1];
    p.w_in = (const float*)(gcf)q[2];
    p.cmp_pos = (const float*)(gcf)q[3];
    p.cmp_w1 = (const float*)(gcf)q[4];
    p.cmp_w2 = (const float*)(gcf)q[5];
    p.w_nsa_up = (const float*)(gcf)q[6];
    p.pool_w = (const float*)(gcf)q[7];
    p.pool_scale = (const float*)(gcf)q[8];
    p.w_pool_up = (const float*)(gcf)q[9];
    p.w_out = (const float*)(gcf)q[10];
    p.norm_ffn_g = (const float*)(gcf)q[11];
    p.ffn_w_gate = (const float*)(gcf)q[12];
    p.ffn_w_up = (const float*)(gcf)q[13];
    p.ffn_w_down = (const float*)(gcf)q[14];
    p.moe_w_router = (const float*)(gcf)q[15];
    p.moe_b_router = (const float*)(gcf)q[16];
    p.moe_w_gate = (const float*)(gcf)q[17];
    p.moe_w_up = (const float*)(gcf)q[18];
    p.moe_w_down = (const float*)(gcf)q[19];
    p.final_norm_g = (const float*)(gcf)q[20];
    p.out = (float*)(gf)q[21]; p.ws = (unsigned char*)(guc)q[22];
    { const unsigned long long w = q[23]; p.ph_lo = (int)(unsigned)w; p.ph_hi = (int)(unsigned)(w >> 32); }
#endif
}
__device__ __forceinline__ unsigned char* launder_ws(unsigned char* w) {
    unsigned long long v = (unsigned long long)w; asm volatile("" : "+s"(v)); return (unsigned char*)(__attribute__((address_space(1))) unsigned char*)v; }
__device__ __forceinline__ XcdBarrier relaunder_bar(const XcdBarrier& b) {
    unsigned long long pb = (unsigned long long)b.bar; unsigned x = b.x; unsigned st = (unsigned)(unsigned long long)(uintptr_t)b.st;
    asm volatile("" : "+s"(pb), "+s"(x), "+s"(st));
    XcdBarrier r; r.bar = (unsigned*)(__attribute__((address_space(1))) unsigned*)pb; r.x = x; r.st = (volatile LAS unsigned*)(uintptr_t)st; return r; }
constexpr int NTHR = 512, NWAVES = 8;
constexpr int RING_BYTES = 131072, MISC_OFF = RING_BYTES, LDS_BYTES = 147456;

struct Ctx { LAS unsigned char* lds; int tid, lane, wave, G, bid; };

__device__ __forceinline__ void tconv_tile(const Ctx& F, const float* src, int ld, int col0, int nvalid, int k0, bf16_t* dst, int ldd, int r0, int kd0) {
    LAS float* tile = (LAS float*)(F.lds + F.wave * 8704);
    const int lane = F.lane, kq = lane >> 3, c4 = (lane & 7) * 4;
    f32x4 v[8];
#pragma unroll
    for (int i = 0; i < 8; ++i) { const float* sp = src + (size_t)(k0 + kq + 8 * i) * ld + col0 + c4;
        if (c4 + 3 < nvalid) v[i] = *(const f32x4*)sp;
        else { v[i][0] = (c4 < nvalid) ? sp[0] : 0.f; v[i][1] = (c4 + 1 < nvalid) ? sp[1] : 0.f; v[i][2] = (c4 + 2 < nvalid) ? sp[2] : 0.f; v[i][3] = 0.f; } }
    LDS_FENCE();
#pragma unroll
    for (int i = 0; i < 8; ++i)
#pragma unroll
        for (int j = 0; j < 4; ++j) tile[(c4 + j) * 68 + kq + 8 * i] = v[i][j];
    LDS_FENCE();
    { const int c = lane >> 1, kh = (lane & 1) * 32; u32x4 w[4];
#pragma unroll
      for (int q = 0; q < 4; ++q) { const f32x4 a = *(const LAS f32x4*)(tile + c * 68 + kh + q * 8), b = *(const LAS f32x4*)(tile + c * 68 + kh + q * 8 + 4); w[q] = pg8::pack8(a, b); }
      bf16_t* dp = dst + (size_t)(r0 + c) * ldd + kd0 + k0 + kh;
#pragma unroll
      for (int q = 0; q < 4; ++q) *(u32x4*)(dp + q * 8) = w[q]; }
}
template <class Fn>
__device__ __forceinline__ void tconv_matrix(const Ctx& F, int nrow_tiles, int K, bf16_t* dst, int ldd, int kd0, int& wcur, Fn fn) {
    const int nk = K / 64, ntiles = nrow_tiles * nk, NW = F.G * NWAVES, me = F.bid * NWAVES + F.wave;
    int first = (me - (wcur % NW) + NW) % NW;
    for (int i = first; i < ntiles; i += NW) { const int rt = i % nrow_tiles, kt = i / nrow_tiles;   const float* src; int ld, col0, nvalid; fn(rt, src, ld, col0, nvalid);
        tconv_tile(F, src, ld, col0, nvalid, kt * 64, dst, ldd, rt * 32, kd0); }
    wcur += ntiles;
}

__device__ __forceinline__ void phase_prep_mixer(const Ctx& F, const Params& p, int L, int part = 3) {
    unsigned char* ws = p.ws; int wcur = 0;
    if (part & 1) {
    { const float* base = p.w_in + (size_t)L * 1024 * INC_;
      tconv_matrix(F, 128, 1024, (bf16_t*)(ws + W_IN_(L)), 1024, 0, wcur, [&](int rt, const float*& src, int& ld, int& col0, int& nvalid) {
          const int r0 = rt * 32; src = base; ld = INC_; nvalid = 32;
          if (r0 < 1280) col0 = r0;
          else if (r0 < 1792) col0 = 1304 + (r0 - 1280);
          else if (r0 < 3840) { const int loc = r0 - 1792, q8 = loc >> 8, within = loc & 255, half = within >> 7, i = within & 127; col0 = 1816 + half * 1024 + q8 * 128 + i; }
          else if (r0 == 3840) { col0 = 1280; nvalid = 24; }
          else { col0 = 0; nvalid = 0; } }); }
    { const float* base = p.cmp_w1 + (size_t)L * 2 * 2048 * 256;
      tconv_matrix(F, 16, 2048, (bf16_t*)(ws + W_C1_(L)), 2048, 0, wcur, [&](int rt, const float*& src, int& ld, int& col0, int& nvalid) {
          src = base + (size_t)(rt >> 3) * 2048 * 256; ld = 256; col0 = (rt & 7) * 32; nvalid = 32; }); }
    { const float* base = p.w_nsa_up + (size_t)L * 512 * 1024;
      tconv_matrix(F, 32, 512, (bf16_t*)(ws + W_M_(L)), 1024, 0, wcur, [&](int rt, const float*& src, int& ld, int& col0, int& nvalid) { src = base; ld = 1024; col0 = rt * 32; nvalid = 32; }); }
    { const float* base = p.w_out + (size_t)L * 1024 * 1024;
      tconv_matrix(F, 32, 1024, (bf16_t*)(ws + W_O_(L)), 1024, 0, wcur, [&](int rt, const float*& src, int& ld, int& col0, int& nvalid) { src = base; ld = 1024; col0 = rt * 32; nvalid = 32; }); }
    }
    if (!(part & 2)) return;
    if (F.bid >= F.G - 16) { const int wq = F.bid - (F.G - 16), kv = wq >> 3, cb = (wq & 7) * 32, c = F.tid & 31, kg = F.tid >> 5;
        const float* pos = p.cmp_pos + (size_t)(L * 2 + kv) * 2048; const float* w1 = p.cmp_w1 + (size_t)(L * 2 + kv) * 2048 * 256 + cb + c; float s = 0.f;
#pragma unroll 32
        for (int j = 0; j < 128; ++j) { const int k = kg + 16 * j; s += pos[k] * w1[(size_t)k * 256]; }
        LAS float* red = (LAS float*)(F.lds + 73728); red[F.tid] = s; __syncthreads();
        if (F.tid < 32) { float t = 0.f;
#pragma unroll
            for (int q = 0; q < 16; ++q) t += red[q * 32 + F.tid];
            ((float*)(ws + W_B1_(L)))[kv * 256 + cb + F.tid] = t; }
        __syncthreads(); }
    if (F.bid < 64) { const int g = F.bid >> 4, c0 = (F.bid & 15) * 8; const float* pw = p.pool_w + (size_t)L * 4 * 128 * 128 + (size_t)(g * 128 + c0) * 128; const float* ps = p.pool_scale + (size_t)L * 512 + g * 128;
        const float* wp = p.w_pool_up + (size_t)L * 512 * 1024 + (size_t)(g * 128) * 1024 + F.tid * 2; bf16_t* wm = (bf16_t*)(ws + W_M_(L));
        LAS float* al = (LAS float*)(F.lds + 73728);
        for (int i = F.tid; i < 1024; i += NTHR) { const int d = i >> 3, cc = i & 7; al[i] = pw[cc * 128 + d] * ps[d]; }
        __syncthreads();
        f32x2 acc[8];
#pragma unroll
        for (int cc = 0; cc < 8; ++cc) acc[cc] = (f32x2){0.f, 0.f};
#pragma unroll 16
        for (int d = 0; d < 128; ++d) { const f32x2 w = *(const f32x2*)(wp + (size_t)d * 1024); const f32x4 a0 = *(const LAS f32x4*)(al + d * 8), a1 = *(const LAS f32x4*)(al + d * 8 + 4);
            acc[0] += w * a0[0]; acc[1] += w * a0[1]; acc[2] += w * a0[2]; acc[3] += w * a0[3]; acc[4] += w * a1[0]; acc[5] += w * a1[1]; acc[6] += w * a1[2]; acc[7] += w * a1[3]; }
#pragma unroll
        for (int i = 0; i < 2; ++i) { u32x4 o; o.x = cvt_pk_bf16(acc[0][i], acc[1][i]); o.y = cvt_pk_bf16(acc[2][i], acc[3][i]); o.z = cvt_pk_bf16(acc[4][i], acc[5][i]); o.w = cvt_pk_bf16(acc[6][i], acc[7][i]);
            *(u32x4*)(wm + (size_t)(F.tid * 2 + i) * 1024 + 512 + g * 128 + c0) = o; }
        __syncthreads(); }
}

__device__ __forceinline__ void phase_prep_ffn(const Ctx& F, const Params& p, int L) {
    unsigned char* ws = p.ws; int wcur = 0;
    const int j = L >> 1;
    if ((L & 1) == 0) {
        const float* wg = p.ffn_w_gate + (size_t)j * 1024 * DFF_; const float* wu = p.ffn_w_up + (size_t)j * 1024 * DFF_; const float* wd = p.ffn_w_down + (size_t)j * DFF_ * 1024;
        tconv_matrix(F, 2 * DFF_ / 32, 1024, (bf16_t*)(ws + W_FF), 1024, 0, wcur, [&](int rt, const float*& src, int& ld, int& col0, int& nvalid) {
            const int r0 = rt * 32, pn = r0 >> 8, within = r0 & 255, half = within >> 7, i = within & 127; src = half ? wu : wg; ld = DFF_; col0 = pn * 128 + i; nvalid = 32; });
        tconv_matrix(F, 32, DFF_, (bf16_t*)(ws + W_FFD_DENSE), DFF_, 0, wcur, [&](int rt, const float*& src, int& ld, int& col0, int& nvalid) { src = wd; ld = 1024; col0 = rt * 32; nvalid = 32; });
    } else {
        const float* wg = p.moe_w_gate + (size_t)j * NE_ * 1024 * DFE_; const float* wu = p.moe_w_up + (size_t)j * NE_ * 1024 * DFE_; const float* wd = p.moe_w_down + (size_t)j * NE_ * DFE_ * 1024;
        constexpr int RT_E = 2 * DFE_ / 32;
        tconv_matrix(F, NE_ * RT_E, 1024, (bf16_t*)(ws + W_FF), 1024, 0, wcur, [&](int rt, const float*& src, int& ld, int& col0, int& nvalid) {
            const int e = rt / RT_E, r0 = (rt % RT_E) * 32, pn = r0 >> 8, within = r0 & 255, half = within >> 7, i = within & 127;
            src = (half ? wu : wg) + (size_t)e * 1024 * DFE_; ld = DFE_; col0 = pn * 128 + i; nvalid = 32; });
        tconv_matrix(F, NE_ * 32, DFE_, (bf16_t*)(ws + W_FFD_MOE), DFE_, 0, wcur, [&](int rt, const float*& src, int& ld, int& col0, int& nvalid) {
            const int e = rt >> 5; src = wd + (size_t)e * DFE_ * 1024; ld = 1024; col0 = (rt & 31) * 32; nvalid = 32; });
    }
}

__device__ __forceinline__ void phase_norm_b8(const Ctx& F, const bf16_t* h, const float* g, bf16_t* dst) {
    f32x4 gv[4];
#pragma unroll
    for (int i = 0; i < 2; ++i) { gv[2 * i] = *(const f32x4*)(g + i * 512 + F.lane * 8); gv[2 * i + 1] = *(const f32x4*)(g + i * 512 + F.lane * 8 + 4); }
    u32x4 nx[2]; { const int row = F.bid * NWAVES + F.wave; if (row < T_) {
#pragma unroll
        for (int i = 0; i < 2; ++i) nx[i] = *(const u32x4*)(h + (size_t)row * 1024 + i * 512 + F.lane * 8); } }
    for (int row = F.bid * NWAVES + F.wave; row < T_; row += F.G * NWAVES) {
        f32x4 v[4]; float ss = 0.f;
#pragma unroll
        for (int i = 0; i < 2; ++i) pg8::unpack8(nx[i], v[2 * i], v[2 * i + 1]);
        { const int nrow = row + F.G * NWAVES; if (nrow < T_) {
#pragma unroll
            for (int i = 0; i < 2; ++i) nx[i] = *(const u32x4*)(h + (size_t)nrow * 1024 + i * 512 + F.lane * 8); } }
#pragma unroll
        for (int i = 0; i < 4; ++i) ss += v[i][0] * v[i][0] + v[i][1] * v[i][1] + v[i][2] * v[i][2] + v[i][3] * v[i][3];
        ss = wave_sum(ss); const float r = rsqrtf(ss * (1.0f / 1024.0f) + 1e-6f);
#pragma unroll
        for (int i = 0; i < 2; ++i) *(u32x4*)(dst + (size_t)row * 1024 + i * 512 + F.lane * 8) = pg8::pack8(v[2 * i] * r * gv[2 * i], v[2 * i + 1] * r * gv[2 * i + 1]);
    }
}
template <bool HBF> __device__ __forceinline__ f32x4 ld_h4(const void* h, size_t off) {
    if (HBF) { const u32x2 w = *(const u32x2*)((const bf16_t*)h + off); f32x4 v; v[0] = __uint_as_float(w.x << 16); v[1] = __uint_as_float(w.x & 0xffff0000u); v[2] = __uint_as_float(w.y << 16); v[3] = __uint_as_float(w.y & 0xffff0000u); return v; }
    else return *(const f32x4*)((const float*)h + off);
}
template <bool ROUTER, bool HBF>
__device__ __forceinline__ void phase_norm(const Ctx& F, const void* h, const float* g, bf16_t* dst, const float* wrt, const float* brt, int* cnt, int* tok_e, int* tok_p, float* tok_g, int* row_tok, int* row_dst) {
    LAS float* wl = (LAS float*)F.lds;
    LAS int* lcnt = (LAS int*)(F.lds + 32768);
    if (ROUTER) {
        if (F.tid < 8) lcnt[F.tid] = 0;
        for (int i = F.tid; i < 8192; i += NTHR) { const int c = i >> 3, e = i & 7; wl[((((c >> 8) * 4 + (c & 3)) * 2 + (e >> 2)) * 64 + ((c >> 2) & 63)) * 4 + (e & 3)] = wrt[i]; }
        for (int i = F.bid * NTHR + F.tid; i < MOE_ROWS; i += F.G * NTHR) { row_tok[i] = 0; row_dst[i] = YB_DUMMY; }
        __syncthreads();
    }
    f32x4 gv[4];
#pragma unroll
    for (int i = 0; i < 4; ++i) gv[i] = *(const f32x4*)(g + i * 256 + F.lane * 4);
    const bool blk = ROUTER && (T_ % (F.G * NWAVES) == 0); const int rpw = T_ / (F.G * NWAVES);
    const int rstep = blk ? 1 : F.G * NWAVES, rbeg = blk ? (F.bid * NWAVES + F.wave) * rpw : F.bid * NWAVES + F.wave, rend = blk ? rbeg + rpw : T_;
    f32x4 vnx[4]; { const int row = rbeg; if (row < rend) {
#pragma unroll
        for (int i = 0; i < 4; ++i) vnx[i] = ld_h4<HBF>(h, (size_t)row * 1024 + i * 256 + F.lane * 4); } }
    for (int row = rbeg; row < rend; row += rstep) {
        f32x4 v[4]; float ss = 0.f;
#pragma unroll
        for (int i = 0; i < 4; ++i) v[i] = vnx[i];
        { const int nrow = row + rstep; if (nrow < rend) {
#pragma unroll
            for (int i = 0; i < 4; ++i) vnx[i] = ld_h4<HBF>(h, (size_t)nrow * 1024 + i * 256 + F.lane * 4); } }
#pragma unroll
        for (int i = 0; i < 4; ++i) ss += v[i][0] * v[i][0] + v[i][1] * v[i][1] + v[i][2] * v[i][2] + v[i][3] * v[i][3];
        ss = wave_sum(ss); const float r = rsqrtf(ss * (1.0f / 1024.0f) + 1e-6f);
#pragma unroll
        for (int i = 0; i < 4; ++i) { v[i] = v[i] * r * gv[i]; u32x2 w; w.x = cvt_pk_bf16(v[i][0], v[i][1]); w.y = cvt_pk_bf16(v[i][2], v[i][3]); *(u32x2*)(dst + (size_t)row * 1024 + i * 256 + F.lane * 4) = w; }
        if (ROUTER) {
            f32x2 lgp[4];
#pragma unroll
            for (int e = 0; e < 4; ++e) lgp[e] = (f32x2){0.f, 0.f};
#pragma unroll
            for (int i = 0; i < 4; ++i)
#pragma unroll
                for (int j = 0; j < 4; ++j) { const LAS float* wp = wl + (((i * 4 + j) * 2) * 64 + F.lane) * 4; const f32x4 w0 = *(const LAS f32x4*)(wp), w1 = *(const LAS f32x4*)(wp + 256); const f32x2 f = {v[i][j], v[i][j]};
                    lgp[0] += f * (f32x2){w0[0], w0[1]}; lgp[1] += f * (f32x2){w0[2], w0[3]}; lgp[2] += f * (f32x2){w1[0], w1[1]}; lgp[3] += f * (f32x2){w1[2], w1[3]}; }
            float lg[8];
#pragma unroll
            for (int e = 0; e < 8; ++e) lg[e] = wave_sum(lgp[e >> 1][e & 1]) + brt[e];
            if (F.lane == 0) {
                int e0 = 0; float b0 = lg[0];
#pragma unroll
                for (int e = 1; e < 8; ++e) if (lg[e] > b0) { b0 = lg[e]; e0 = e; }
                int e1 = -1; float b1 = -3.0e38f;
#pragma unroll
                for (int e = 0; e < 8; ++e) if (e != e0 && lg[e] > b1) { b1 = lg[e]; e1 = e; }
                const float g0 = 1.0f / (1.0f + __expf(b1 - b0)), g1 = 1.0f - g0;
                const int p0 = __hip_atomic_fetch_add(&lcnt[e0], 1, __ATOMIC_RELAXED, __HIP_MEMORY_SCOPE_WORKGROUP), p1 = __hip_atomic_fetch_add(&lcnt[e1], 1, __ATOMIC_RELAXED, __HIP_MEMORY_SCOPE_WORKGROUP);
                tok_e[row * 2] = e0; tok_e[row * 2 + 1] = e1; tok_p[row * 2] = p0; tok_p[row * 2 + 1] = p1; tok_g[row * 2] = g0; tok_g[row * 2 + 1] = g1;
            }
        }
    }
    if (ROUTER) { __syncthreads(); if (F.tid < 8) cnt[F.bid * 8 + F.tid] = lcnt[F.tid]; }
}

__device__ __forceinline__ void phase_final_norm(const Ctx& F, float* h, const float* g) {
    f32x4 gv[4];
#pragma unroll
    for (int i = 0; i < 4; ++i) gv[i] = *(const f32x4*)(g + i * 256 + F.lane * 4);
    for (int row = F.bid * NWAVES + F.wave; row < T_; row += F.G * NWAVES) {
        float* hr = h + (size_t)row * 1024; f32x4 v[4]; float ss = 0.f;
#pragma unroll
        for (int i = 0; i < 4; ++i) { v[i] = *(const f32x4*)(hr + i * 256 + F.lane * 4); ss += v[i][0] * v[i][0] + v[i][1] * v[i][1] + v[i][2] * v[i][2] + v[i][3] * v[i][3]; }
        ss = wave_sum(ss); const float r = rsqrtf(ss * (1.0f / 1024.0f) + 1e-6f);
#pragma unroll
        for (int i = 0; i < 4; ++i) *(f32x4*)(hr + i * 256 + F.lane * 4) = v[i] * r * gv[i];
    }
}

__device__ __forceinline__ void phase_pool(const Ctx& F, const bf16_t* U, bf16_t* OP) {
    for (int idx = F.bid * NTHR + F.tid; idx < T_; idx += F.G * NTHR) {
        const int seg = idx >> 6, c8 = (idx & 63) * 8, grp = c8 >> 7, w = 2 << grp, t0 = seg * 64, tt0 = t0 & (S_ - 1);
        const bf16_t* up = U + (size_t)t0 * 512 + c8; bf16_t* op = OP + (size_t)t0 * 1024 + 512 + c8;
        f32x4 s0 = (f32x4){0.f, 0.f, 0.f, 0.f}, s1 = s0;
        if (tt0 > 0) { u32x4 pv[16];
#pragma unroll
            for (int i = 1; i <= 16; ++i) { const int off = ((i <= w) ? i : 1) * 512; pv[i - 1] = *(const u32x4*)(up - off); }
#pragma unroll
            for (int i = 1; i <= 16; ++i) if (i <= w) { f32x4 a, b; pg8::unpack8(pv[i - 1], a, b); s0 += a; s1 += b; } }
#pragma unroll 1
        for (int tb = 0; tb < 64; tb += 8) { u32x4 nv[8], ov[8];
#pragma unroll
            for (int j = 0; j < 8; ++j) { const int t = tb + j; nv[j] = *(const u32x4*)(up + (size_t)t * 512); const int tt = tt0 + t; const int oo = ((tt >= w) ? t - w : t) * 512; ov[j] = *(const u32x4*)(up + oo); }
#pragma unroll
            for (int j = 0; j < 8; ++j) { const int t = tb + j, tt = tt0 + t; f32x4 a, b; pg8::unpack8(nv[j], a, b); s0 += a; s1 += b;
                if (tt >= w) { f32x4 oa, ob; pg8::unpack8(ov[j], oa, ob); s0 -= oa; s1 -= ob; }
                const float inv = 1.0f / (float)((tt + 1 < w) ? tt + 1 : w);
                *(u32x4*)(op + (size_t)t * 1024) = pg8::pack8(s0 * inv - a, s1 * inv - b); } }
    }
}

__device__ __forceinline__ void phase_cmp2(const Ctx& F, const bf16_t* HC, const float* w2  , bf16_t* KC, int blk0, int blk1, int bstep) {
    LAS float* wl = (LAS float*)F.lds;
    LAS float* hl = (LAS float*)(F.lds + 65536) + F.wave * 2048;
    int kv_loaded = -1;
    for (int blk = blk0; blk < blk1; blk += bstep) {
        const int kv = blk >> 7;
        if (kv != kv_loaded) { __syncthreads(); for (int i = F.tid; i < 256 * 64 / 4; i += NTHR) *(LAS f32x4*)(wl + i * 4) = *(const f32x4*)(w2 + (size_t)kv * 256 * 64 + i * 4); kv_loaded = kv; __syncthreads(); }
        const int row0 = blk * 64 + F.wave * 8;
        LDS_FENCE();
#pragma unroll
        for (int r = 0; r < 8; ++r) { const u32x2 wv = *(const u32x2*)(HC + (size_t)(row0 + r) * 256 + F.lane * 4);
            hl[(F.lane * 4 + 0) * 8 + r] = __uint_as_float(wv.x << 16); hl[(F.lane * 4 + 1) * 8 + r] = __uint_as_float(wv.x & 0xffff0000u);
            hl[(F.lane * 4 + 2) * 8 + r] = __uint_as_float(wv.y << 16); hl[(F.lane * 4 + 3) * 8 + r] = __uint_as_float(wv.y & 0xffff0000u); }
        LDS_FENCE();
        float acc[8];
#pragma unroll
        for (int r = 0; r < 8; ++r) acc[r] = 0.f;
#pragma unroll 4
        for (int c = 0; c < 256; ++c) { const float w = wl[c * 64 + F.lane]; const f32x4 h0 = *(const LAS f32x4*)(hl + c * 8), h1 = *(const LAS f32x4*)(hl + c * 8 + 4);
            acc[0] += h0[0] * w; acc[1] += h0[1] * w; acc[2] += h0[2] * w; acc[3] += h0[3] * w; acc[4] += h1[0] * w; acc[5] += h1[1] * w; acc[6] += h1[2] * w; acc[7] += h1[3] * w; }
#pragma unroll
        for (int r = 0; r < 8; ++r) KC[(size_t)(row0 + r) * 64 + F.lane] = f2bf(acc[r]);
    }
}

__device__ __forceinline__ void dot4_row(const bf16_t* krow, const LAS float* qf, float (&s)[4]) {
    s[0] = s[1] = s[2] = s[3] = 0.f;
    u32x4 kr[8];
#pragma unroll
    for (int c = 0; c < 8; ++c) kr[c] = *(const u32x4*)(krow + c * 8);
#pragma unroll
    for (int c = 0; c < 8; ++c) { const u32x4 wv = kr[c]; f32x4 a, b; pg8::unpack8(wv, a, b); asm volatile("" ::: "memory");
#pragma unroll
        for (int i = 0; i < 4; ++i) { const f32x4 q0 = *(const LAS f32x4*)(qf + (c * 8 + i) * 4), q1 = *(const LAS f32x4*)(qf + (c * 8 + 4 + i) * 4);
            s[0] += a[i] * q0[0]; s[1] += a[i] * q0[1]; s[2] += a[i] * q0[2]; s[3] += a[i] * q0[3];
            s[0] += b[i] * q1[0]; s[1] += b[i] * q1[1]; s[2] += b[i] * q1[2]; s[3] += b[i] * q1[3]; } }
}
__device__ __forceinline__ void softmax4(LAS float* sc, int nkeys, int lane) {
    float m[4] = {-3.0e38f, -3.0e38f, -3.0e38f, -3.0e38f};
    for (int n = lane; n < nkeys; n += 64) { const f32x4 v = *(const LAS f32x4*)(sc + n * 4); m[0] = fmaxf(m[0], v[0]); m[1] = fmaxf(m[1], v[1]); m[2] = fmaxf(m[2], v[2]); m[3] = fmaxf(m[3], v[3]); }
#pragma unroll
    for (int h = 0; h < 4; ++h) m[h] = wave_max(m[h]);
    float l[4] = {0.f, 0.f, 0.f, 0.f};
    for (int n = lane; n < nkeys; n += 64) { f32x4 v = *(const LAS f32x4*)(sc + n * 4);
#pragma unroll
        for (int h = 0; h < 4; ++h) { v[h] = __expf(v[h] - m[h]); l[h] += v[h]; }
        *(LAS f32x4*)(sc + n * 4) = v; }
#pragma unroll
    for (int h = 0; h < 4; ++h) l[h] = 1.0f / wave_sum(l[h]);
    for (int n = lane; n < nkeys; n += 64) { f32x4 v = *(const LAS f32x4*)(sc + n * 4); v[0] *= l[0]; v[1] *= l[1]; v[2] *= l[2]; v[3] *= l[3]; *(LAS f32x4*)(sc + n * 4) = v; }
    LDS_FENCE();
}

__device__ __forceinline__ void phase_attn_naive(const Ctx& F, const bf16_t* Q, const bf16_t* KV, const bf16_t* KC, const float* GT, bf16_t* OP) {
    LAS float* qf = (LAS float*)(F.lds + F.wave * 16384);
    LAS float* sc = qf + 256;
    const int lane = F.lane;
    for (int unit = F.bid * NWAVES + F.wave; unit < T_ * 2; unit += F.G * NWAVES) {
        const int tt = unit & (S_ - 1), bg = unit >> 11, g = bg & 1, b = bg >> 1; const size_t t = (size_t)b * S_ + tt;
        LDS_FENCE();
#pragma unroll
        for (int h = 0; h < 4; ++h) qf[lane * 4 + h] = bf2f(Q[t * 512 + (g * 4 + h) * 64 + lane]);
        LDS_FENCE();
        const bf16_t* kc = KC + ((size_t)(0 * 2 + g) * 4096 + b * 128) * 64; const bf16_t* vc = KC + ((size_t)(1 * 2 + g) * 4096 + b * 128) * 64;
        const bf16_t* ks = KV + ((size_t)(2 * 2 + g) * T_ + (size_t)b * S_) * 64; const bf16_t* vs = KV + ((size_t)(3 * 2 + g) * T_ + (size_t)b * S_) * 64;
        const bf16_t* kw = KV + ((size_t)(4 * 2 + g) * T_ + (size_t)b * S_) * 64; const bf16_t* vw = KV + ((size_t)(5 * 2 + g) * T_ + (size_t)b * S_) * 64;
        int ncv = (tt >= 31) ? ((tt - 31) >> 4) + 1 : 0; if (ncv > 127) ncv = 127;
        float ocmp[4] = {0.f, 0.f, 0.f, 0.f}; float imp = 0.f;
        if (ncv > 0) {
#pragma unroll 1
            for (int n0 = 0; n0 < 128; n0 += 64) { const int n = n0 + lane; float s[4]; dot4_row(kc + (size_t)(n < 127 ? n : 126) * 64, qf, s);
                f32x4 v; const bool ok = n < ncv; v[0] = ok ? s[0] : -INFINITY; v[1] = ok ? s[1] : -INFINITY; v[2] = ok ? s[2] : -INFINITY; v[3] = ok ? s[3] : -INFINITY; *(LAS f32x4*)(sc + n * 4) = v; }
            LDS_FENCE();
            softmax4(sc, 128, lane);
            if (lane < 32) { const int nlo = (4 * lane - 1 < 0) ? 0 : 4 * lane - 1, nhi = (4 * lane + 3 > 126) ? 126 : 4 * lane + 3;
                for (int n = nlo; n <= nhi; ++n) { const f32x4 v = *(const LAS f32x4*)(sc + n * 4); imp += (v[0] + v[1]) + (v[2] + v[3]); } }
#pragma unroll 4
            for (int n = 0; n < ncv; ++n) { const f32x4 pv = *(const LAS f32x4*)(sc + n * 4); const float v = bf2f(vc[(size_t)n * 64 + lane]);
                ocmp[0] += pv[0] * v; ocmp[1] += pv[1] * v; ocmp[2] += pv[2] * v; ocmp[3] += pv[3] * v; }
        }
        const int cur = tt >> 6; unsigned selmask = 0u;
        { float val = -3.0e38f; if (lane < 32) { val = imp; if (lane > cur) val = -1.0e9f; if (lane == 0 || lane == cur) val = 1.0e9f; }
          for (int it = 0; it < 8; ++it) { float bv = val; int bi = lane;
#pragma unroll
              for (int o = 32; o >= 1; o >>= 1) { const float ov = __shfl_xor(bv, o); const int oi = __shfl_xor(bi, o); if (ov > bv || (ov == bv && oi < bi)) { bv = ov; bi = oi; } }
              selmask |= 1u << (bi & 31); if (lane == bi) val = -INFINITY; } }
        float osel[4] = {0.f, 0.f, 0.f, 0.f};
        { LDS_FENCE(); unsigned mk = selmask;
#pragma unroll 1
          for (int k = 0; k < 8; ++k) { const int j = __builtin_ctz(mk); mk &= mk - 1u; const int kpos = 64 * j + lane; float s[4]; dot4_row(ks + (size_t)kpos * 64, qf, s);
              const bool ok = kpos <= tt; f32x4 v; v[0] = ok ? s[0] : -INFINITY; v[1] = ok ? s[1] : -INFINITY; v[2] = ok ? s[2] : -INFINITY; v[3] = ok ? s[3] : -INFINITY; *(LAS f32x4*)(sc + (k * 64 + lane) * 4) = v; }
          LDS_FENCE();
          softmax4(sc, 512, lane);
          mk = selmask;
#pragma unroll 1
          for (int k = 0; k < 8; ++k) { const int j = __builtin_ctz(mk); mk &= mk - 1u; if (j > cur) continue; const bf16_t* vb = vs + (size_t)j * 64 * 64;
#pragma unroll 4
              for (int i = 0; i < 64; ++i) { const f32x4 pv = *(const LAS f32x4*)(sc + (k * 64 + i) * 4); const float v = bf2f(vb[(size_t)i * 64 + lane]);
                  osel[0] += pv[0] * v; osel[1] += pv[1] * v; osel[2] += pv[2] * v; osel[3] += pv[3] * v; } } }
        float owin[4] = {0.f, 0.f, 0.f, 0.f};
        { LDS_FENCE();
#pragma unroll 1
          for (int k = 0; k < 8; ++k) { const int kpos = tt - 511 + 64 * k + lane; const bool ok = kpos >= 0; float s[4]; dot4_row(kw + (size_t)(ok ? kpos : 0) * 64, qf, s);
              f32x4 v; v[0] = ok ? s[0] : -INFINITY; v[1] = ok ? s[1] : -INFINITY; v[2] = ok ? s[2] : -INFINITY; v[3] = ok ? s[3] : -INFINITY; *(LAS f32x4*)(sc + (k * 64 + lane) * 4) = v; }
          LDS_FENCE();
          softmax4(sc, 512, lane);
          const int k0 = (tt >= 511) ? 0 : 511 - tt;
#pragma unroll 4
          for (int i = k0; i < 512; ++i) { const f32x4 pv = *(const LAS f32x4*)(sc + i * 4); const float v = bf2f(vw[(size_t)(tt - 511 + i) * 64 + lane]);
              owin[0] += pv[0] * v; owin[1] += pv[1] * v; owin[2] += pv[2] * v; owin[3] += pv[3] * v; } }
        const float* gt = GT + t * 32 + g * 12;
#pragma unroll
        for (int h = 0; h < 4; ++h) { const float o = gt[h * 3] * ocmp[h] + gt[h * 3 + 1] * osel[h] + gt[h * 3 + 2] * owin[h]; OP[t * 1024 + (g * 4 + h) * 64 + lane] = f2bf(o); }
    }
}

namespace att {
typedef float f32x16 __attribute__((ext_vector_type(16)));
typedef short s16x4 __attribute__((ext_vector_type(4)));
constexpr float C2 = 1.4426950408889634f, NEG = -1.0e30f, THR = 8.0f;
constexpr int KSTR = 128;
__device__ __forceinline__ int koff(int row, int ch) { return row * 128 + ((ch ^ ((row >> 1) & 7)) << 4); }
constexpr int L_KB0 = 0, L_KB1 = 9216, L_VB0 = 18432, L_VB1 = 26624, L_WSF = 34816, L_SELM = 36864, L_GT = 37888, L_IMPA = 40960, L_IMPB = L_IMPA + 4 * 64 * 33 * 4, L_STG = L_IMPA, L_KB2 = L_IMPB + 4 * 64 * 33 * 4, L_VB2 = L_KB2 + 9216;
#define MFMA32(a, b, c) __builtin_amdgcn_mfma_f32_32x32x16_bf16(a, b, c, 0, 0, 0)
__device__ __forceinline__ int crow(int r, int hi) { return (r & 3) + 8 * (r >> 2) + 4 * hi; }
__device__ __forceinline__ s16x4 vtr(const LAS char* p) { return __builtin_bit_cast(s16x4, __builtin_amdgcn_ds_read_tr16_b64_v4i16((LAS s16x4*)p)); }
__device__ __forceinline__ float halfswap_sum(float x) { auto rr = __builtin_amdgcn_permlane32_swap(__float_as_uint(x), __float_as_uint(x), false, false); return __uint_as_float(rr[0]) + __uint_as_float(rr[1]); }
__device__ __forceinline__ float halfswap_max(float x) { auto rr = __builtin_amdgcn_permlane32_swap(__float_as_uint(x), __float_as_uint(x), false, false); return fmaxf(__uint_as_float(rr[0]), __uint_as_float(rr[1])); }
__device__ __forceinline__ float max3f(float a, float b, float c) { float d; asm("v_max3_f32 %0, %1, %2, %3" : "=v"(d) : "v"(a), "v"(b), "v"(c)); return d; }
__device__ __forceinline__ float rowmax32(const f32x16& p0, const f32x16& p1) {
    float a = max3f(p0[0], p1[0], p0[1]), b = max3f(p1[1], p0[2], p1[2]);
#pragma unroll
    for (int r = 3; r < 15; r += 2) { a = max3f(a, p0[r], p1[r]); b = max3f(b, p0[r + 1], p1[r + 1]); }
    a = max3f(a, p0[15], p1[15]);
    return halfswap_max(max3f(a, b, b)); }
__device__ __forceinline__ void mask_tile(f32x16& p0, f32x16& p1, int hi, int thr_hi, int thr_lo) {
#pragma unroll
    for (int r = 0; r < 16; ++r) { const int kk = crow(r, hi); if (kk > thr_hi || kk <= thr_lo) p0[r] = NEG; if (kk + 32 > thr_hi || kk + 32 <= thr_lo) p1[r] = NEG; } }
__device__ __forceinline__ void qk_tile(const LAS char* kb, const bf16x8 (&qr)[4], f32x16& p0, f32x16& p1, int r32, int hi) {
    bf16x8 kf[8];
#pragma unroll
    for (int d0 = 0; d0 < 4; ++d0)
#pragma unroll
        for (int n = 0; n < 2; ++n) kf[2 * d0 + n] = *(const LAS bf16x8*)(kb + koff(r32 + 32 * n, 2 * d0 + hi));
    f32x16 z = {};
    p0 = MFMA32(kf[0], qr[0], z); p1 = MFMA32(kf[1], qr[0], z);
#pragma unroll
    for (int d0 = 1; d0 < 4; ++d0) { p0 = MFMA32(kf[2 * d0], qr[d0], p0); p1 = MFMA32(kf[2 * d0 + 1], qr[d0], p1); }
}
__device__ __forceinline__ void pack_p(const f32x16& p0, const f32x16& p1, bf16x8 (&pa)[4]) {
#pragma unroll
    for (int k = 0; k < 2; ++k) { u32x4 w; w.x = cvt_pk_bf16(p0[8 * k], p0[8 * k + 1]); w.y = cvt_pk_bf16(p0[8 * k + 2], p0[8 * k + 3]); w.z = cvt_pk_bf16(p0[8 * k + 4], p0[8 * k + 5]); w.w = cvt_pk_bf16(p0[8 * k + 6], p0[8 * k + 7]); pa[k] = __builtin_bit_cast(bf16x8, w);
        u32x4 v; v.x = cvt_pk_bf16(p1[8 * k], p1[8 * k + 1]); v.y = cvt_pk_bf16(p1[8 * k + 2], p1[8 * k + 3]); v.z = cvt_pk_bf16(p1[8 * k + 4], p1[8 * k + 5]); v.w = cvt_pk_bf16(p1[8 * k + 6], p1[8 * k + 7]); pa[2 + k] = __builtin_bit_cast(bf16x8, v); }
}
__device__ __forceinline__ void pv_pa(const LAS char* vb, const bf16x8 (&pa)[4], f32x16 (&o)[2], int lane, int hi) {
    const LAS char* vp = vb + ((lane >> 4) & 1) * 32 + (lane & 3) * 8 + (4 * hi + ((lane & 15) >> 2)) * 64;
#pragma unroll
    for (int k = 0; k < 4; ++k)
#pragma unroll
        for (int d0 = 0; d0 < 2; ++d0) { const s16x4 lo = vtr(vp + d0 * 4096 + k * 1024), hh = vtr(vp + d0 * 4096 + k * 1024 + 512);
            const bf16x8 vf = (bf16x8){lo[0], lo[1], lo[2], lo[3], hh[0], hh[1], hh[2], hh[3]};
            o[d0] = MFMA32(pa[k], vf, o[d0]); }
}
__device__ __forceinline__ void pv_tile(const LAS char* vb, const f32x16& p0, const f32x16& p1, f32x16 (&o)[2], int lane, int hi) { bf16x8 pa[4]; pack_p(p0, p1, pa); pv_pa(vb, pa, o, lane, hi); }
struct St { f32x16 o[2]; float mhat, l; };
__device__ __forceinline__ void softmax_step(f32x16& p0, f32x16& p1, St& st, bool first, bool rowok, LAS float* wsf, int r32, int hi) {
    float rm = rowmax32(p0, p1); rm = rowok ? rm : -3.0e38f; bool resc = false;
    if (first) st.mhat = rm;
    else { const float gr = rm - st.mhat; if (__any(gr > THR)) { const float dl = fmaxf(gr, 0.f); st.mhat += dl; const float f = __builtin_amdgcn_exp2f(-dl); st.l *= f; if (hi == 0) wsf[r32] = f; resc = true; } }
    const float nmh = rowok ? -st.mhat : -INFINITY; float sa = 0.f, sb = 0.f;
#pragma unroll
    for (int r = 0; r < 16; ++r) { p0[r] = __builtin_amdgcn_exp2f(p0[r] + nmh); p1[r] = __builtin_amdgcn_exp2f(p1[r] + nmh); sa += p0[r]; sb += p1[r]; }
    st.l += sa + sb;
    if (resc) { LDS_FENCE();
#pragma unroll
        for (int r = 0; r < 16; ++r) { const float f = wsf[crow(r, hi)]; st.o[0][r] *= f; st.o[1][r] *= f; } }
}
__device__ __forceinline__ void finish_pass(const St& st, unsigned (&omix)[16], bool firstpass, LAS float* wsf, const LAS float* gtl, int gidx, int ph, int r32, int hi, bool rowvalid) {
    const float lt = halfswap_sum(st.l); const float inv = rowvalid ? 1.0f / lt : 0.f;
    LDS_FENCE(); if (hi == 0) wsf[32 + r32] = inv; LDS_FENCE();
#pragma unroll
    for (int r = 0; r < 16; ++r) { const int q = crow(r, hi); const float s = wsf[32 + q] * gtl[(32 * ph + q) * 12 + gidx];
        float a = st.o[0][r] * s, b = st.o[1][r] * s;
        if (!firstpass) { a += __uint_as_float(omix[r] << 16); b += __uint_as_float(omix[r] & 0xffff0000u); }
        omix[r] = cvt_pk_bf16(a, b); }
}
__device__ __forceinline__ void tile_to_lds(LAS char* kb, LAS char* vb, int tid, const u32x4 kr, const u32x4 vr) {
    const int key = tid >> 3, ch = tid & 7;
    *(LAS u32x4*)(kb + koff(key, ch)) = kr; *(LAS u32x4*)(vb + (ch >> 2) * 4096 + key * 64 + (ch & 3) * 16) = vr; }
__device__ __forceinline__ void dma_tile(LAS char* kb, LAS char* vb, const bf16_t* ksrc, const bf16_t* vsrc, int tid, int wave) {
    { const int row = tid >> 3, ch = (tid & 7) ^ ((row >> 1) & 7); __builtin_amdgcn_global_load_lds((const unsigned*)(ksrc + row * 64 + ch * 8), (LAS unsigned*)(kb + wave * 1024), 16, 0, 0); }
    { const int dh = tid >> 8, row = (tid >> 2) & 63, q = tid & 3; __builtin_amdgcn_global_load_lds((const unsigned*)(vsrc + row * 64 + (dh * 4 + q) * 8), (LAS unsigned*)(vb + wave * 1024), 16, 0, 0); }
}
}

__device__ __forceinline__ void phase_attn(const Ctx& F, const bf16_t* Q, const bf16_t* KV, const bf16_t* KC, const float* GT, bf16_t* OP) {
    using namespace att;
    LAS char* L = (LAS char*)F.lds; const int wave = F.wave, head = wave & 3, ph = wave >> 2;
    LAS float* wsf = (LAS float*)(L + L_WSF) + wave * 64; LAS unsigned* selm = (LAS unsigned*)(L + L_SELM); LAS float* gtl = (LAS float*)(L + L_GT);
    LAS float* impa = (LAS float*)(L + L_IMPA); LAS float* impb = (LAS float*)(L + L_IMPB);
    LAS char* kbuf[2] = {L + L_KB0, L + L_KB1}; LAS char* vbuf[2] = {L + L_VB0, L + L_VB1};
    for (int it = F.bid; it < 1024; it += F.G) {
        const int wq = it & 255, kq = it >> 8, bg = (wq & 7) + 8 * (wq >> 5), pr = ((wq >> 3) & 3) * 4 + kq, b = bg >> 1, g = bg & 1;
#pragma unroll 1
        for (int half = 0; half < 2; ++half) {
            int tid = F.tid; asm volatile("" : "+v"(tid)); const int lane = tid & 63, r32 = lane & 31, hi = lane >> 5, posl = 32 * ph + r32;
            const int c = half ? 31 - pr : pr; const size_t t0 = (size_t)b * S_ + 64 * c; const int tt = 64 * c + posl;
            bf16x8 qr[4];
#pragma unroll
            for (int d0 = 0; d0 < 4; ++d0) qr[d0] = *(const bf16x8*)(Q + (t0 + posl) * 512 + (g * 4 + head) * 64 + d0 * 16 + hi * 8);
            for (int i = tid; i < 768; i += NTHR) gtl[i] = GT[(t0 + i / 12) * 32 + g * 12 + (i % 12)];
            dma_tile(L + L_KB2, L + L_VB2, KV + ((size_t)(2 * 2 + g) * T_ + (size_t)b * S_) * 64, KV + ((size_t)(3 * 2 + g) * T_ + (size_t)b * S_) * 64, tid, wave);
            unsigned omix[16]; int pass_slot = 2;
            { const bf16_t* kc = KC + ((size_t)(0 * 2 + g) * 4096 + b * 128) * 64; const bf16_t* vc = KC + ((size_t)(1 * 2 + g) * 4096 + b * 128) * 64;
              const u32x4 k0 = *(const u32x4*)(kc + tid * 8), v0 = *(const u32x4*)(vc + tid * 8), k1 = *(const u32x4*)(kc + 4096 + tid * 8), v1 = *(const u32x4*)(vc + 4096 + tid * 8);
              tile_to_lds(kbuf[0], vbuf[0], tid, k0, v0); tile_to_lds(kbuf[1], vbuf[1], tid, k1, v1);
              __syncthreads();
              const int nv = (tt >= 31) ? ((tt - 31) >> 4) : -1; const bool rowvalid = nv >= 0;
              const bool two = c >= 16;
              f32x16 a0, a1, b0, b1; qk_tile(kbuf[0], qr, a0, a1, r32, hi); if (two) qk_tile(kbuf[1], qr, b0, b1, r32, hi); else { b0 = f32x16{}; b1 = f32x16{}; }
              mask_tile(a0, a1, hi, rowvalid ? nv : 1000, -1); mask_tile(b0, b1, hi, (rowvalid || !two) ? nv - 64 : 1000, -1);
              St st; st.o[0] = f32x16{}; st.o[1] = f32x16{};
              st.mhat = fmaxf(rowmax32(a0, a1), rowmax32(b0, b1)); const float nmh = -st.mhat; float sacc = 0.f;
#pragma unroll
              for (int r = 0; r < 16; ++r) { a0[r] = __builtin_amdgcn_exp2f(a0[r] + nmh); a1[r] = __builtin_amdgcn_exp2f(a1[r] + nmh);
                  b0[r] = __builtin_amdgcn_exp2f(b0[r] + nmh); b1[r] = __builtin_amdgcn_exp2f(b1[r] + nmh); sacc += (a0[r] + a1[r]) + (b0[r] + b1[r]); }
              st.l = sacc;
              if (c >= 8) {
                  const float inv = rowvalid ? 1.0f / halfswap_sum(sacc) : 0.f; LAS float* ia = impa + (head * 64 + posl) * 33; LAS float* ib = impb + (head * 64 + posl) * 33;
#pragma unroll
                  for (int rr = 0; rr < 4; ++rr) {
                      { const int jb = 0 + 2 * rr + hi; ia[jb] = ((a0[4 * rr] + a0[4 * rr + 1]) + (a0[4 * rr + 2] + a0[4 * rr + 3])) * inv; ib[jb + 1] = a0[4 * rr + 3] * inv; }
                      { const int jb = 8 + 2 * rr + hi; ia[jb] = ((a1[4 * rr] + a1[4 * rr + 1]) + (a1[4 * rr + 2] + a1[4 * rr + 3])) * inv; ib[jb + 1] = a1[4 * rr + 3] * inv; }
                      { const int jb = 16 + 2 * rr + hi; ia[jb] = ((b0[4 * rr] + b0[4 * rr + 1]) + (b0[4 * rr + 2] + b0[4 * rr + 3])) * inv; ib[jb + 1] = b0[4 * rr + 3] * inv; }
                      { const int jb = 24 + 2 * rr + hi; ia[jb] = ((b1[4 * rr] + b1[4 * rr + 1]) + (b1[4 * rr + 2] + b1[4 * rr + 3])) * inv; if (jb + 1 < 32) ib[jb + 1] = b1[4 * rr + 3] * inv; }
                  }
              }
              pv_tile(vbuf[0], a0, a1, st.o, lane, hi); if (two) pv_tile(vbuf[1], b0, b1, st.o, lane, hi);
              finish_pass(st, omix, true, wsf, gtl, head * 3 + 0, ph, r32, hi, rowvalid);
            }
            __syncthreads();
            if (c >= 8) {
                LAS float* impf = (LAS float*)(L + L_KB0);
                { const int p = tid >> 3, j0 = (tid & 7) * 4; f32x4 v;
#pragma unroll
                  for (int jj = 0; jj < 4; ++jj) { const int j = j0 + jj; float val = 0.f;
#pragma unroll
                      for (int h = 0; h < 4; ++h) val += impa[(h * 64 + p) * 33 + j];
                      if (j > 0) {
#pragma unroll
                          for (int h = 0; h < 4; ++h) val += impb[(h * 64 + p) * 33 + j]; }
                      if (j > c) val = -1.0e9f; if (j == 0 || j == c) val = 1.0e9f; v[jj] = val; }
                  *(LAS f32x4*)(impf + p * 32 + j0) = v; }
                __syncthreads();
#pragma unroll 1
                for (int i2 = 0; i2 < 4; ++i2) { const int p = wave * 8 + 2 * i2 + hi, j = r32; const float my = impf[p * 32 + j]; int rank = 0;
#pragma unroll
                    for (int q = 0; q < 8; ++q) { const f32x4 v = *(const LAS f32x4*)(impf + p * 32 + q * 4);
#pragma unroll
                        for (int e = 0; e < 4; ++e) { const int i = q * 4 + e; rank += (v[e] > my || (v[e] == my && i < j)) ? 1 : 0; } }
                    const unsigned long long bal = __builtin_amdgcn_ballot_w64(rank < 8);
                    if (j == 0) selm[p] = hi ? (unsigned)(bal >> 32) : (unsigned)bal; }
            } else if (tid < 64) selm[tid] = (2u << c) - 1u;
            __syncthreads();
            const unsigned mysel = selm[posl]; unsigned uni = selm[lane];
#pragma unroll
            for (int o = 32; o >= 1; o >>= 1) uni |= __shfl_xor(uni, o);
            uni = __builtin_amdgcn_readfirstlane(uni) & ((c >= 31) ? 0xffffffffu : ((2u << c) - 1u));
#pragma unroll 1
            for (int pass = 0; pass < 2; ++pass) {
                const bf16_t* kb = KV + ((size_t)((2 + 2 * pass) * 2 + g) * T_ + (size_t)b * S_) * 64; const bf16_t* vb = KV + ((size_t)((3 + 2 * pass) * 2 + g) * T_ + (size_t)b * S_) * 64;
                unsigned um; if (pass == 0) um = uni; else { const int jl = (c >= 8) ? c - 8 : 0; um = ((c >= 31) ? 0xffffffffu : ((2u << c) - 1u)) & ~((1u << jl) - 1u); }
                int j = pass == 0 ? __builtin_ctz(um) : 31 - __builtin_clz(um); um &= ~(1u << j);
                f32x16 oo[2]; oo[0] = f32x16{}; oo[1] = f32x16{}; f32x16 ls = {}; float mhat = 0.f; int sb = pass_slot, sprev = 0; f32x16 pp0, pp1;
                u32x4 onesw = {0x3f803f80u, 0x3f803f80u, 0x3f803f80u, 0x3f803f80u}; asm volatile("" : "+v"(onesw)); const bf16x8 ones = __builtin_bit_cast(bf16x8, onesw);
                u32x4 qx = {0u, 0u, 0u, 0u}; asm volatile("" : "+v"(qx));
#define KSLOT(s) (L + ((s) == 0 ? L_KB0 : ((s) == 1 ? L_KB1 : L_KB2)))
#define VSLOT(s) (L + ((s) == 0 ? L_VB0 : ((s) == 1 ? L_VB1 : L_VB2)))
#define NEXT_TILE(jn) do { jn = -1; const int sn_ = (sb == 2) ? 0 : sb + 1; \
        if (um) { jn = pass == 0 ? __builtin_ctz(um) : 31 - __builtin_clz(um); um &= ~(1u << jn); dma_tile(KSLOT(sn_), VSLOT(sn_), kb + (size_t)jn * 4096, vb + (size_t)jn * 4096, tid, wave); } \
        else if (pass == 0) { dma_tile(KSLOT(sn_), VSLOT(sn_), KV + ((size_t)(4 * 2 + g) * T_ + (size_t)b * S_) * 64 + (size_t)c * 4096, KV + ((size_t)(5 * 2 + g) * T_ + (size_t)b * S_) * 64 + (size_t)c * 4096, tid, wave); pass_slot = sn_; } } while (0)
                bool more;
                {
                    int j1; NEXT_TILE(j1);
                    f32x16 p0, p1; qk_tile(KSLOT(sb), qr, p0, p1, r32, hi);
                    const bool rowok = (pass != 0) || (((mysel >> j) & 1u) != 0u);
                    if (j == c) mask_tile(p0, p1, hi, posl, -1); else if (pass == 1 && j == c - 8) mask_tile(p0, p1, hi, 1000, posl);
                    const float rm = rowmax32(p0, p1); mhat = __uint_as_float(cvt_pk_bf16(rm, rm) << 16); const float nmh = rowok ? -mhat : -INFINITY;
#pragma unroll
                    for (int r = 0; r < 16; ++r) { p0[r] = __builtin_amdgcn_exp2f(p0[r] + nmh); p1[r] = __builtin_amdgcn_exp2f(p1[r] + nmh); }
                    pp0 = p0; pp1 = p1; sprev = sb; more = j1 >= 0;
                    if (more) { __syncthreads(); sb = (sb == 2) ? 0 : sb + 1; j = j1; }
                }
                while (more) {
                    int j1; NEXT_TILE(j1);
                    const bool rowok = (pass != 0) || (((mysel >> j) & 1u) != 0u);
                    qx.x = hi ? 0u : (rowok ? (__float_as_uint(-mhat) >> 16) : 0xFF7Fu);
                    f32x16 p0, p1; u32x4 pw[4];
                    { const LAS char* kbp = KSLOT(sb); bf16x8 kf[8];
#pragma unroll
                      for (int d0 = 0; d0 < 2; ++d0) { kf[2 * d0] = *(const LAS bf16x8*)(kbp + koff(r32, 2 * d0 + hi)); kf[2 * d0 + 1] = *(const LAS bf16x8*)(kbp + koff(r32 + 32, 2 * d0 + hi)); }
                      f32x16 z = {}; p0 = MFMA32(ones, __builtin_bit_cast(bf16x8, qx), z); p1 = MFMA32(ones, __builtin_bit_cast(bf16x8, qx), z);
#pragma unroll
                      for (int i = 0; i < 8; ++i) { const int d0 = i >> 1;
                          if (i < 4) { const int n = i + 4; kf[n] = *(const LAS bf16x8*)(kbp + koff(r32 + 32 * (n & 1), 2 * (n >> 1) + hi)); }
                          if ((i & 1) == 0) p0 = MFMA32(kf[2 * d0], qr[d0], p0); else p1 = MFMA32(kf[2 * d0 + 1], qr[d0], p1);
#pragma unroll
                          for (int w = 2 * i; w < 2 * i + 2; ++w) { const int t = w >> 2, e = 2 * (w & 3); unsigned v;
                              if (t < 2) v = cvt_pk_bf16(pp0[8 * t + e], pp0[8 * t + e + 1]); else v = cvt_pk_bf16(pp1[8 * (t - 2) + e], pp1[8 * (t - 2) + e + 1]);
                              asm volatile("" : "+v"(v)); pw[t][w & 3] = v; }
                          __builtin_amdgcn_sched_barrier(0); }
                    }
                    if (j == c) mask_tile(p0, p1, hi, posl, -1); else if (pass == 1 && j == c - 8) mask_tile(p0, p1, hi, 1000, posl);
                    float gr = rowmax32(p0, p1); bool resc = false;
                    if (__any(gr > THR)) { const float dl = fmaxf(gr, 0.f); const float nm = __uint_as_float(cvt_pk_bf16(mhat + dl, mhat + dl) << 16); const float dq = nm - mhat; mhat = nm;
                        const float f = __builtin_amdgcn_exp2f(-dq); if (hi == 0) wsf[r32] = f; resc = true;
#pragma unroll
                        for (int r = 0; r < 16; ++r) { p0[r] -= dq; p1[r] -= dq; } }
                    asm volatile("" : "+v"(p0), "+v"(p1));
                    { const LAS char* vp = VSLOT(sprev) + ((lane >> 4) & 1) * 32 + (lane & 3) * 8 + (4 * hi + ((lane & 15) >> 2)) * 64;
#pragma unroll
                      for (int i = 0; i < 8; ++i) { const int k = i >> 1, d0 = i & 1;
                          const s16x4 lo = vtr(vp + d0 * 4096 + k * 1024), hh = vtr(vp + d0 * 4096 + k * 1024 + 512);
                          const bf16x8 vf = (bf16x8){lo[0], lo[1], lo[2], lo[3], hh[0], hh[1], hh[2], hh[3]};
                          oo[d0] = MFMA32(__builtin_bit_cast(bf16x8, pw[k]), vf, oo[d0]);
                          if (d0 == 1) ls = MFMA32(__builtin_bit_cast(bf16x8, pw[k]), ones, ls);
#pragma unroll
                          for (int r = 0; r < 4; ++r) { if (i < 4) p0[4 * i + r] = __builtin_amdgcn_exp2f(p0[4 * i + r]); else p1[4 * (i - 4) + r] = __builtin_amdgcn_exp2f(p1[4 * (i - 4) + r]); }
                          asm volatile("" : "+v"(p0), "+v"(p1));
                          __builtin_amdgcn_sched_barrier(0); }
                    }
                    if (resc) { LDS_FENCE();
#pragma unroll
                        for (int r = 0; r < 16; ++r) { const float f = wsf[crow(r, hi)]; oo[0][r] *= f; oo[1][r] *= f; ls[r] *= f; } }
                    pp0 = p0; pp1 = p1; sprev = sb; more = j1 >= 0;
                    if (more) { __syncthreads(); sb = (sb == 2) ? 0 : sb + 1; j = j1; }
                }
                { bf16x8 ppa[4]; pack_p(pp0, pp1, ppa);
                  pv_pa(VSLOT(sprev), ppa, oo, lane, hi);
#pragma unroll
                  for (int k = 0; k < 4; ++k) ls = MFMA32(ppa[k], ones, ls); }
#undef KSLOT
#undef VSLOT
#undef NEXT_TILE
#pragma unroll
                for (int r = 0; r < 16; ++r) { const int q = crow(r, hi); const float sc_ = __builtin_amdgcn_rcpf(ls[r]) * gtl[(32 * ph + q) * 12 + head * 3 + 1 + pass];
                    const float a = oo[0][r] * sc_ + __uint_as_float(omix[r] << 16), bq = oo[1][r] * sc_ + __uint_as_float(omix[r] & 0xffff0000u);
                    omix[r] = cvt_pk_bf16(a, bq); }
                __syncthreads();
            }
            { bf16_t* Ow = OP + (t0 + 32 * ph) * 1024 + (g * 4 + head) * 64; LAS bf16_t* stg = (LAS bf16_t*)(L + L_STG) + wave * 2048;
#pragma unroll
              for (int r = 0; r < 16; ++r) { const int orow = crow(r, hi);
#pragma unroll
                  for (int d0 = 0; d0 < 2; ++d0) stg[orow * 64 + d0 * 32 + r32] = (bf16_t)(d0 ? (omix[r] >> 16) : (omix[r] & 0xffffu)); }
              LDS_FENCE();
#pragma unroll
              for (int i = 0; i < 4; ++i) { const int row = i * 8 + (lane >> 3), ch = lane & 7; *(u32x4*)(Ow + (size_t)row * 1024 + ch * 8) = *(const LAS u32x4*)(stg + row * 64 + ch * 8); } }
            __syncthreads();
        }
    }
}

__device__ __forceinline__ int moe_tile_starts(const int* cnt, int (&ts)[NE_ + 1]) {
    int acc = 0;
#pragma unroll
    for (int e = 0; e < NE_; ++e) { ts[e] = acc; acc += (cnt[e] + 255) >> 8; }
    ts[NE_] = acc; return acc;
}
__device__ __forceinline__ void phase_moe_assign(const Ctx& F, const int* wgcnt, int* cnt, const int* tok_e, const int* tok_p, int* row_tok, int* row_dst) {
    LAS int* pre = (LAS int*)F.lds;
    for (int i = F.tid; i < F.G * 8; i += NTHR) pre[i] = wgcnt[i];
    __syncthreads();
    if (F.tid < 8) { int acc = 0; for (int w = 0; w < F.G; ++w) { const int v = pre[w * 8 + F.tid]; pre[w * 8 + F.tid] = acc; acc += v; } pre[F.G * 8 + F.tid] = acc; if (F.bid == 0) cnt[F.tid] = acc; }
    __syncthreads();
    int ts[NE_ + 1]; { int acc = 0;
#pragma unroll
        for (int e = 0; e < NE_; ++e) { ts[e] = acc; acc += (pre[F.G * 8 + e] + 255) >> 8; } ts[NE_] = acc; }
    for (int idx = F.bid * NTHR + F.tid; idx < T_ * 2; idx += F.G * NTHR) { const int e = tok_e[idx]; int st = 0;
#pragma unroll
        for (int k = 0; k < NE_; ++k) st = (k == e) ? ts[k] : st;
        const int r = idx >> 1, w = (T_ % (F.G * NWAVES) == 0) ? r / (T_ / F.G) : (r % (F.G * NWAVES)) / NWAVES;
        const int row = st * 256 + pre[w * 8 + e] + tok_p[idx]; row_tok[row] = r; row_dst[row] = idx; }
}
__device__ __forceinline__ void phase_moe_gather(const Ctx& F, const bf16_t* f, const int* row_tok, bf16_t* xs, int nrows) {
    for (int r = F.bid * NWAVES + F.wave; r < nrows; r += F.G * NWAVES) { const bf16_t* src = f + (size_t)row_tok[r] * 1024; bf16_t* dst = xs + (size_t)r * 1024;
        *(u32x4*)(dst + F.lane * 8) = *(const u32x4*)(src + F.lane * 8); *(u32x4*)(dst + 512 + F.lane * 8) = *(const u32x4*)(src + 512 + F.lane * 8); }
}
__device__ __forceinline__ void phase_moe_combine(const Ctx& F, bf16_t* h, float* outf, const bf16_t* yb, const float* tok_g, const float* g, bf16_t* dst) {
    f32x4 gv[4];
#pragma unroll
    for (int i = 0; i < 2; ++i) { gv[2 * i] = *(const f32x4*)(g + i * 512 + F.lane * 8); gv[2 * i + 1] = *(const f32x4*)(g + i * 512 + F.lane * 8 + 4); }
    u32x4 nh[2], ny0[2], ny1[2]; float ng0 = 0.f, ng1 = 0.f;
#define CMB_LOAD(row_) do { const int r_ = (row_); ng0 = tok_g[r_ * 2]; ng1 = tok_g[r_ * 2 + 1]; _Pragma("unroll") for (int i = 0; i < 2; ++i) { const int c = i * 512 + F.lane * 8; \
        nh[i] = *(const u32x4*)(h + (size_t)r_ * 1024 + c); ny0[i] = *(const u32x4*)(yb + (size_t)(r_ * 2) * 1024 + c); ny1[i] = *(const u32x4*)(yb + (size_t)(r_ * 2 + 1) * 1024 + c); } } while (0)
    { const int row = F.bid * NWAVES + F.wave; if (row < T_) CMB_LOAD(row); }
    for (int row = F.bid * NWAVES + F.wave; row < T_; row += F.G * NWAVES) { const float g0 = ng0, g1 = ng1; bf16_t* hr = h + (size_t)row * 1024; f32x4 v[4]; float ss = 0.f;
#pragma unroll
        for (int i = 0; i < 2; ++i) { f32x4 ha, hb, a0, b0, a1, b1; pg8::unpack8(nh[i], ha, hb); pg8::unpack8(ny0[i], a0, b0); pg8::unpack8(ny1[i], a1, b1);
            v[2 * i] = ha + a0 * g0 + a1 * g1; v[2 * i + 1] = hb + b0 * g0 + b1 * g1; }
#pragma unroll
        for (int i = 0; i < 4; ++i) ss += v[i][0] * v[i][0] + v[i][1] * v[i][1] + v[i][2] * v[i][2] + v[i][3] * v[i][3];
        { const int nrow = row + F.G * NWAVES; if (nrow < T_) CMB_LOAD(nrow); }
        ss = wave_sum(ss); const float r = rsqrtf(ss * (1.0f / 1024.0f) + 1e-6f);
        if (dst) {
#pragma unroll
            for (int i = 0; i < 2; ++i) { const int c = i * 512 + F.lane * 8; *(u32x4*)(hr + c) = pg8::pack8(v[2 * i], v[2 * i + 1]);
                *(u32x4*)(dst + (size_t)row * 1024 + c) = pg8::pack8(v[2 * i] * r * gv[2 * i], v[2 * i + 1] * r * gv[2 * i + 1]); }
        } else {
#pragma unroll
            for (int i = 0; i < 2; ++i) { const int c = i * 512 + F.lane * 8; *(f32x4*)(outf + (size_t)row * 1024 + c) = v[2 * i] * r * gv[2 * i]; *(f32x4*)(outf + (size_t)row * 1024 + c + 4) = v[2 * i + 1] * r * gv[2 * i + 1]; }
        }
    }
#undef CMB_LOAD
}

#define bufA ((bf16_t*)(ws + WS_BUFA))
#define Qb ((bf16_t*)(ws + R1_Q))
#define KVb ((bf16_t*)(ws + R1_KV))
#define Ub ((bf16_t*)(ws + R1_U))
#define GTb ((float*)(ws + R1_GT))
#define RATIOb ((bf16_t*)(ws + R1_RATIO))
#define S1b ((bf16_t*)(ws + R1_S1))
#define MERGEDb ((bf16_t*)(ws + R1_MERGED))
#define HCb ((bf16_t*)(ws + WS_HC))
#define KCb ((bf16_t*)(ws + WS_KC))
#define tok_e ((int*)(ws + WS_TOKE))
#define tok_p ((int*)(ws + WS_TOKP))
#define tok_g ((float*)(ws + WS_TOKG))
#define row_tok ((int*)(ws + WS_ROWT))
#define row_dst ((int*)(ws + WS_ROWD))
template <unsigned TMASK>
__global__ void __launch_bounds__(NTHR, 2) fwd(Params p0) {
    extern __shared__ __attribute__((aligned(16))) unsigned char lds_raw[];
    Ctx F; F.lds = (LAS unsigned char*)lds_raw; F.tid = threadIdx.x; F.lane = F.tid & 63; F.wave = __builtin_amdgcn_readfirstlane(F.tid >> 6); F.G = gridDim.x; F.bid = blockIdx.x;
    volatile LAS unsigned* MISC = (volatile LAS unsigned*)(F.lds + MISC_OFF);
    if (F.tid < 64) MISC[F.tid] = 0u;
    __syncthreads();
    XcdBarrier bar; bar.bar = (unsigned*)(p0.ws + WS_CTL); bar.x = 0; bar.st = nullptr;
    if (!MK_PER_PHASE) bar = xcd_barrier_post((unsigned*)(p0.ws + WS_CTL), MISC + 8);
    const int lo = p0.ph_lo, hi = p0.ph_hi; int ph = 0;
#define PH_BEGIN(k) if constexpr ((TMASK >> (k)) & 1u) if (ph >= lo && ph < hi) { Params p; load_params(p); unsigned char* ws = launder_ws(p.ws); asm volatile("v_mbcnt_lo_u32_b32 %0, -1, 0\n\tv_mbcnt_hi_u32_b32 %0, -1, %0" : "=v"(F.lane)); F.wave = __builtin_amdgcn_readfirstlane(F.wave); asm volatile("" : "+s"(F.wave)); F.tid = F.wave * 64 + F.lane;
#define PH_END   if (ph + 1 < hi) { if (!MK_PER_PHASE) xcd_barrier(relaunder_bar(bar)); } } ++ph;

    for (int L = 0; L < DEPTH_; ++L) {
        const int j = L >> 1; const bool moe = (L & 1) != 0;
#define HB ((bf16_t*)(ws + WS_H))
#define cnt ((int*)(ws + WS_CTL + CTL_CNT) + j * 16)
#define wgcnt ((int*)(ws + WS_CTL + 20480) + j * 2048)
        if (L == 0 || ((L - 1) & 1) == 0) {
        PH_BEGIN(0)
            if (L == 0) phase_prep_mixer(F, p, 0);
            if (L == 0) phase_norm<false, false>(F, p.x, p.norm_mix_g, bufA, nullptr, nullptr, nullptr, nullptr, nullptr, nullptr, nullptr, nullptr);
            else phase_norm_b8(F, HB, p.norm_mix_g + (size_t)L * 1024, bufA);
        PH_END
        }
        PH_BEGIN(1)
            pg8::Gemm g{bufA, (const bf16_t*)(ws + W_IN_(L)), 1024, 1024}; pg8::Order S; S.init(T_ / 256, 16, F.G, F.bid);
            pg8::EpiProj E{Qb, KVb, Ub, GTb, RATIOb, S1b};
            pg8::gemm_phase<pg8::EpiProj>(F.lds, F.wave, g, S, E);
        PH_END
        PH_BEGIN(2)
            if (F.bid < 64) { pg8::Gemm g{KVb, (const bf16_t*)(ws + W_C1_(L)), 1024, 2048}; pg8::Order S; S.init(64, 1, 64, F.bid); S.mode = 1; S.pbdiv = 32;
                pg8::EpiCmpH E{HCb, (const float*)(ws + W_B1_(L))};
                pg8::gemm_phase<pg8::EpiCmpH>(F.lds, F.wave, g, S, E);
                pg8::Unit u0; S.next(0, u0); asm volatile("s_waitcnt vmcnt(0)" ::: "memory"); __syncthreads();
                phase_cmp2(F, HCb, p.cmp_w2 + (size_t)L * 2 * 256 * 64, KCb, u0.pm * 4, u0.pm * 4 + 4, 1); }
            else { Ctx F2 = F; F2.bid = F.bid - 64; F2.G = F.G - 64;
                phase_pool(F2, Ub, bufA); phase_prep_ffn(F2, p, L); if (L + 1 < DEPTH_) phase_prep_mixer(F2, p, L + 1); }
        PH_END
        PH_BEGIN(4)
            phase_attn(F, Qb, KVb, KCb, GTb, bufA);
        PH_END
        PH_BEGIN(5)
            pg8::Gemm g{bufA, (const bf16_t*)(ws + W_M_(L)), 1024, 1024}; pg8::Order S; S.init(T_ / 256, 4, F.G, F.bid);
            pg8::EpiMerge E{RATIOb, S1b, MERGEDb};
            pg8::gemm_phase<pg8::EpiMerge>(F.lds, F.wave, g, S, E);
        PH_END
        PH_BEGIN(6)
            pg8::Gemm g{MERGEDb, (const bf16_t*)(ws + W_O_(L)), 1024, 1024}; pg8::Order S; S.init(T_ / 256, 4, F.G, F.bid);
            pg8::EpiResid E{(L == 0) ? (const void*)p.x : (const void*)HB, HB, L == 0};
            pg8::gemm_phase<pg8::EpiResid>(F.lds, F.wave, g, S, E);
        PH_END
        if (!moe) {
            PH_BEGIN(7)
                phase_norm_b8(F, HB, p.norm_ffn_g + (size_t)L * 1024, bufA);
            PH_END
            for (int s = 0; s <= 2; ++s) {
            PH_BEGIN(8)
                constexpr int HROWS = T_ / 2;
                if (s >= 1) { const size_t r0 = (size_t)(s - 1) * HROWS;
                    pg8::Gemm g{(const bf16_t*)(ws + R1_HF) + r0 * DFF_, (const bf16_t*)(ws + W_FFD_DENSE), DFF_, DFF_}; pg8::Order S; S.init(HROWS / 256, 4, F.G, F.bid);
                    pg8::EpiResid E{(const void*)(HB + r0 * 1024), HB + r0 * 1024, false};
                    pg8::gemm_phase<pg8::EpiResid>(F.lds, F.wave, g, S, E); }
                if (s < 2) { const size_t r0 = (size_t)s * HROWS;
                    pg8::Gemm g{bufA + r0 * 1024, (const bf16_t*)(ws + W_FF), 1024, 1024}; pg8::Order S; S.init(HROWS / 256, 2 * DFF_ / 256, F.G, F.bid);
                    pg8::EpiSwiglu E{(bf16_t*)(ws + R1_HF) + r0 * DFF_, DFF_};
                    pg8::gemm_phase<pg8::EpiSwiglu>(F.lds, F.wave, g, S, E); }
            PH_END
            }
        } else {
            PH_BEGIN(10)
                phase_norm<true, true>(F, HB, p.norm_ffn_g + (size_t)L * 1024, bufA, p.moe_w_router + (size_t)j * 1024 * 8, p.moe_b_router + j * 8, wgcnt, tok_e, tok_p, tok_g, row_tok, row_dst);
            PH_END
            PH_BEGIN(11)
                phase_moe_assign(F, wgcnt, cnt, tok_e, tok_p, row_tok, row_dst);
            PH_END
            for (int s = 0; s < MOE_MAX_CHUNKS; ++s) {
                int ts[NE_ + 1]; const int NT = moe_tile_starts((const int*)(p0.ws + WS_CTL + CTL_CNT) + j * 16, ts);
                PH_BEGIN(13)
#define MOE_NTC(c_) ((NT - (c_) * MOE_CH_TILES) < 0 ? 0 : ((NT - (c_) * MOE_CH_TILES) > MOE_CH_TILES ? MOE_CH_TILES : (NT - (c_) * MOE_CH_TILES)))
#define MOE_HM(c_) (ws + ((c_) == MOE_NFULL ? WS_HM2 : (((c_) & 1) ? WS_HM1 : R1_HM)))
#define MOE_DOWN(c_) do { const int c = (c_); int ntc = MOE_NTC(c); if (c == MOE_NFULL && ntc > 8) ntc = 8; const int row0 = c * MOE_CH_TILES * 256; \
                        if (ntc > 0) { pg8::Gemm g{(const bf16_t*)MOE_HM(c), (const bf16_t*)(ws + W_FFD_MOE), DFE_, DFE_}; pg8::Order S; S.init(ntc, 4, F.G, F.bid); S.mode = 2; S.tile0 = c * MOE_CH_TILES; \
                            _Pragma("unroll") for (int k = 0; k <= NE_; ++k) S.ts[k] = ts[k]; \
                            pg8::EpiScatter E{(bf16_t*)(ws + R1_YB), row_dst + row0}; \
                            pg8::gemm_phase<pg8::EpiScatter>(F.lds, F.wave, g, S, E); } } while (0)
#define MOE_UP(c_, nskip_) do { const int c = (c_); int ntc = MOE_NTC(c); if (c == MOE_NFULL && ntc > 8) ntc = 8; const int row0 = c * MOE_CH_TILES * 256; \
                        if (ntc > 0) { pg8::Gemm g{bufA, (const bf16_t*)(ws + W_FF), 1024, 1024}; pg8::Order S; S.init(ntc, 2 * DFE_ / 256, F.G, F.bid); S.mode = 2; S.tile0 = c * MOE_CH_TILES; S.set_skip(nskip_); \
                            _Pragma("unroll") for (int k = 0; k <= NE_; ++k) S.ts[k] = ts[k]; \
                            pg8::EpiSwiglu E{(bf16_t*)MOE_HM(c), DFE_}; \
                            pg8::gemm_phase<pg8::EpiSwiglu, true>(F.lds, F.wave, g, S, E, row_tok + row0); } } while (0)
                    if (s == 0) { MOE_UP(MOE_NFULL, 0); MOE_UP(0, 0); }
                    else { int ntail = MOE_NTC(MOE_NFULL); ntail = ntail > 8 ? 8 : ntail;
                        if (s == 1) MOE_DOWN(MOE_NFULL);
                        MOE_DOWN(s - 1);
                        if (s < MOE_NFULL) MOE_UP(s, s == 1 ? 4 * ntail : 0); }
#undef MOE_NTC
#undef MOE_HM
#undef MOE_DOWN
#undef MOE_UP
                PH_END
            }
            PH_BEGIN(15)
                if (L + 1 < DEPTH_) phase_moe_combine(F, HB, nullptr, (const bf16_t*)(ws + R1_YB), tok_g, p.norm_mix_g + (size_t)(L + 1) * 1024, bufA);
                else phase_moe_combine(F, HB, p.out, (const bf16_t*)(ws + R1_YB), tok_g, p.final_norm_g, nullptr);
            PH_END
        }
    }
#undef PH_BEGIN
#undef PH_END
}

constexpr int N_PHASES = DEPTH_ * 6 - 1 + 2 * 4 + 2 * (2 + MOE_MAX_CHUNKS + 1);
constexpr int N_TYPES = 17;
constexpr unsigned ALL_TYPES = (1u << N_TYPES) - 1u;

typedef void (*kern_t)(Params);
template <int K> struct KernTab { static void fill(kern_t* t) { t[K] = fwd<(1u << K)>; KernTab<K - 1>::fill(t); } };
template <> struct KernTab<-1> { static void fill(kern_t*) {} };

extern "C" void kernel_launch(void* const* d_in, const int* in_sizes, int n_in, void* d_out, int out_size, void* d_ws, size_t ws_size, hipStream_t stream) {
    static int grid = 0;
    static kern_t ktab[N_TYPES + 1];
    static int ptype[N_PHASES];
    if (grid == 0) {
        if (n_in != 21 || out_size != T_ * D_ || ws_size < WS_END) { fprintf(stderr, "kernel_launch: unexpected problem (n_in %d out %d ws %zu need %zu)\n", n_in, out_size, ws_size, (size_t)WS_END); grid = -1; return; }
        int dev = 0, cus = 0;
        if (hipGetDevice(&dev) != hipSuccess || hipDeviceGetAttribute(&cus, hipDeviceAttributeMultiprocessorCount, dev) != hipSuccess) { grid = -1; return; }
#if MK_PER_PHASE
        KernTab<N_TYPES - 1>::fill(ktab);
        for (int k = 0; k < N_TYPES; ++k) if (hipFuncSetAttribute((const void*)ktab[k], hipFuncAttributeMaxDynamicSharedMemorySize, LDS_BYTES) != hipSuccess) { grid = -1; return; }
        { int n = 0; for (int L = 0; L < DEPTH_; ++L) { for (int k = 0; k < 7; ++k) if (k != 3 && (k > 0 || L != 2)) ptype[n++] = k;
              if ((L & 1) == 0) { ptype[n++] = 7; ptype[n++] = 8; ptype[n++] = 8; ptype[n++] = 8; }
              else { ptype[n++] = 10; ptype[n++] = 11; for (int c = 0; c < MOE_MAX_CHUNKS; ++c) ptype[n++] = 13; ptype[n++] = 15; } }
          if (n != N_PHASES) { fprintf(stderr, "phase table mismatch %d\n", n); grid = -1; return; } }
#else
        ktab[N_TYPES] = fwd<ALL_TYPES>;
        if (hipFuncSetAttribute((const void*)ktab[N_TYPES], hipFuncAttributeMaxDynamicSharedMemorySize, LDS_BYTES) != hipSuccess) { grid = -1; return; }
        int per_cu = 0;
        if (hipOccupancyMaxActiveBlocksPerMultiprocessor(&per_cu, (const void*)ktab[N_TYPES], NTHR, LDS_BYTES) != hipSuccess || per_cu < 1) { fprintf(stderr, "kernel_launch: occupancy query reports %d\n", per_cu); }
        (void)hipGetLastError();
#endif
        grid = cus;
    }
    if (grid < 0) return;
    (void)hipMemsetAsync((char*)d_ws + WS_CTL, 0, CTL_BYTES, stream);
    Params p{};
    const float** pp = (const float**)&p;
    for (int i = 0; i < 21; ++i) pp[i] = (const float*)d_in[i];
    p.out = (float*)d_out; p.ws = (unsigned char*)d_ws;
#if MK_PER_PHASE
    for (int ph = 0; ph < N_PHASES; ++ph) { p.ph_lo = ph; p.ph_hi = ph + 1; hipLaunchKernelGGL(ktab[ptype[ph]], dim3(grid), dim3(NTHR), LDS_BYTES, stream, p); }
#else
    p.ph_lo = 0; p.ph_hi = N_PHASES; hipLaunchKernelGGL(ktab[N_TYPES], dim3(grid), dim3(NTHR), LDS_BYTES, stream, p);
#endif
}
```
